# Optimizing an MI355X kernel written in HIP

```python
import jax, jax.numpy as jnp
from jax import lax
import numpy as np

D_MODEL = 1024
BATCH = 8
SEQ = 4096
DEPTH = 2
DEC_BATCH = 8
DEC_SEQ = 32
PAST_LEN = 4096

CHUNK = 64
MLP_CHUNK = 128
W_A = D_MODEL
HEADS_A = 8
HEAD_DIM_A = W_A // HEADS_A
W_B = D_MODEL
POOL_WINDOWS = (2, 4, 8, 16)
N_POOL_GROUPS = len(POOL_WINDOWS)
POOL_GROUP_DIM = W_B // N_POOL_GROUPS
POOL_STATE = max(POOL_WINDOWS) - 1
D_MIX = W_A + W_B
D_IN_PROJ = 3 * W_A + 2 * W_B
EPS = 1e-6

kernel_name = "hybrid_gmlp_pool_stream_step"


def rmsnorm(x, g):
    xf = x.astype(jnp.float32)
    y = xf * lax.rsqrt(jnp.mean(xf * xf, axis=-1, keepdims=True) + EPS)
    return (y * g.astype(jnp.float32)).astype(x.dtype)


def layernorm(x, g, b):
    xf = x.astype(jnp.float32)
    mu = jnp.mean(xf, axis=-1, keepdims=True)
    xc = xf - mu
    y = xc * lax.rsqrt(jnp.mean(xc * xc, axis=-1, keepdims=True) + EPS)
    return (y * g.astype(jnp.float32) + b.astype(jnp.float32)).astype(x.dtype)


def chunk_mlp(v, w_spatial, b_spatial):
    B, T, _ = v.shape
    pad = (-T) % MLP_CHUNK
    vp = jnp.pad(v, ((0, 0), (0, pad), (0, 0)))
    n = (T + pad) // MLP_CHUNK
    vr = vp.reshape(B, n, MLP_CHUNK, HEADS_A, HEAD_DIM_A)
    blk = jnp.arange(MLP_CHUNK) // CHUNK
    mask = blk[None, :] <= blk[:, None]
    w = jnp.where(mask[None], w_spatial, jnp.zeros_like(w_spatial))
    out = jnp.einsum('hij,bnjhc->bnihc', w, vr) + b_spatial.T[None, None, :, :, None]
    return out.reshape(B, n * MLP_CHUNK, W_A)[:, :T]


def pool_mix(x_ext, pos0, w_pool, pool_scale):
    B, L, _ = x_ext.shape
    T = L - POOL_STATE
    xf = x_ext.astype(jnp.float32)
    cs = jnp.concatenate([jnp.zeros((B, 1, W_B), jnp.float32), jnp.cumsum(xf, axis=1)], axis=1)
    x_new = xf[:, POOL_STATE:]
    pos = jnp.arange(T, dtype=jnp.float32) + pos0
    parts = []
    for g, w in enumerate(POOL_WINDOWS):
        sl = slice(g * POOL_GROUP_DIM, (g + 1) * POOL_GROUP_DIM)
        s = cs[:, POOL_STATE + 1:, sl] - cs[:, POOL_STATE + 1 - w:POOL_STATE + 1 - w + T, sl]
        cnt = jnp.minimum(pos + 1.0, float(w))[None, :, None]
        parts.append(s / cnt - x_new[..., sl])
    d = jnp.stack(parts, axis=2)
    out = jnp.einsum('btgc,gcd->btgd', d, w_pool.astype(jnp.float32)).reshape(B, T, W_B)
    return (out * pool_scale.astype(jnp.float32)).astype(x_ext.dtype)


def mixer_layer(x, pool_past, pos0, norm_g, w_in, ln_v_g, ln_v_b, w_spatial, b_spatial,
                w_pool, pool_scale, w_out):
    h = rmsnorm(x, norm_g)
    proj = jnp.einsum('btd,de->bte', h, w_in)
    u, v, z_a, xb, z_b = jnp.split(proj, [W_A, 2 * W_A, 3 * W_A, 3 * W_A + W_B], axis=-1)
    v_n = layernorm(v, ln_v_g, ln_v_b)
    a = u * chunk_mlp(v_n, w_spatial, b_spatial) * jax.nn.silu(z_a)
    x_ext = jnp.concatenate([pool_past.astype(xb.dtype), xb], axis=1)
    b = pool_mix(x_ext, pos0, w_pool, pool_scale) * jax.nn.silu(z_b)
    y = x + jnp.einsum('bte,ed->btd', jnp.concatenate([a, b], axis=-1), w_out)
    return y, x_ext[:, -POOL_STATE:], v_n


def setup_inputs(seed: int = 0) -> dict:
    key = jax.random.key(seed)
    ks = jax.random.split(key, 16)
    f32 = jnp.float32
    x_prompt = jax.random.normal(ks[0], (BATCH, SEQ, D_MODEL), f32)
    x_sample = jax.random.normal(ks[1], (DEC_BATCH, DEC_SEQ, D_MODEL), f32)
    state_pool = jax.random.normal(ks[2], (DEPTH, DEC_BATCH, POOL_STATE, W_B), f32)
    norm_g = 1.0 + 0.05 * jax.random.normal(ks[3], (DEPTH, D_MODEL), f32)
    w_in = jax.random.normal(ks[4], (DEPTH, D_MODEL, D_IN_PROJ), f32) * D_MODEL ** -0.5
    ln_v_g = 1.0 + 0.05 * jax.random.normal(ks[5], (DEPTH, W_A), f32)
    ln_v_b = 0.02 * jax.random.normal(ks[6], (DEPTH, W_A), f32)
    w_spatial = jax.random.normal(ks[7], (DEPTH, HEADS_A, MLP_CHUNK, MLP_CHUNK), f32) * MLP_CHUNK ** -0.5
    b_spatial = 1.0 + 0.1 * jax.random.normal(ks[8], (DEPTH, HEADS_A, MLP_CHUNK), f32)
    w_pool = jax.random.normal(ks[9], (DEPTH, N_POOL_GROUPS, POOL_GROUP_DIM, POOL_GROUP_DIM), f32) * POOL_GROUP_DIM ** -0.5
    pool_scale = 1.0 + 0.1 * jax.random.normal(ks[10], (DEPTH, W_B), f32)
    w_out = jax.random.normal(ks[11], (DEPTH, D_MIX, D_MODEL), f32) * D_MIX ** -0.5
    final_g = 1.0 + 0.05 * jax.random.normal(ks[12], (D_MODEL,), f32)
    return {"x_prompt": x_prompt, "x_sample": x_sample, "state_pool": state_pool,
            "norm_g": norm_g, "w_in": w_in, "ln_v_g": ln_v_g, "ln_v_b": ln_v_b,
            "w_spatial": w_spatial, "b_spatial": b_spatial, "w_pool": w_pool,
            "pool_scale": pool_scale, "w_out": w_out, "final_g": final_g}


def reference(x_prompt, x_sample, state_pool, norm_g, w_in, ln_v_g, ln_v_b, w_spatial,
              b_spatial, w_pool, pool_scale, w_out, final_g):
    xp = x_prompt
    xs = x_sample
    pool_p, pool_s, v_s = [], [], []
    zero_past = jnp.zeros((x_prompt.shape[0], POOL_STATE, W_B), x_prompt.dtype)
    for l in range(DEPTH):
        params = (norm_g[l], w_in[l], ln_v_g[l], ln_v_b[l], w_spatial[l], b_spatial[l],
                  w_pool[l], pool_scale[l], w_out[l])
        xp, new_pool_p, _ = mixer_layer(xp, zero_past, 0, *params)
        xs, new_pool_s, v_rows = mixer_layer(xs, state_pool[l], PAST_LEN, *params)
        pool_p.append(new_pool_p)
        pool_s.append(new_pool_s)
        v_s.append(v_rows)
    y_prompt = rmsnorm(xp, final_g)
    y_sample = rmsnorm(xs, final_g)
    new_state_pool_prompt = jnp.stack(pool_p, axis=0)
    new_state_pool_sample = jnp.stack(pool_s, axis=0)
    new_chunk_v_sample = jnp.stack(v_s, axis=0)
    return (y_prompt, y_sample, new_state_pool_prompt, new_state_pool_sample, new_chunk_v_sample)
```

```cpp
#include <hip/hip_runtime.h>
#include <hip/hip_cooperative_groups.h>
#include <cstdio>
#include <cstdint>
namespace cg = cooperative_groups;

#ifndef MK_COOP
#define MK_PROBES 1
#define MK_COOP 2
#endif

namespace pg8 {
#define PG8_LAS __attribute__((address_space(3)))
typedef unsigned short bf16_t;
typedef short bf16x8 __attribute__((ext_vector_type(8)));
typedef float f32x4 __attribute__((ext_vector_type(4)));
typedef unsigned u32x4 __attribute__((ext_vector_type(4)));
constexpr int BM = 256, BK = 64, HALF = 128, HTB = HALF * BK * 2  , STAGE_BYTES = 8 * HTB, NXCD = 8, WGM = 8;

__host__ __device__ __forceinline__ int lds_byte(int r, int c) { const int st = (r >> 4) * 2 + (c >> 5), rr = r & 15, cc = c & 31, ob = rr * 64 + cc * 2; return st * 1024 + (ob ^ (((ob >> 9) & 1) << 5)); }
__host__ __device__ __forceinline__ void stage_rc(int b, int& R, int& C) { const int st = b / 1024, sb = b % 1024, swz = sb ^ (((sb >> 9) & 1) << 5); R = (st >> 1) * 16 + swz / 64; C = (st & 1) * 32 + (swz % 64) / 2; }
__host__ __device__ __forceinline__ int perm32(int rho) { const int n = rho >> 4, i = rho & 15; return 8 * (i >> 2) + 4 * n + (i & 3); }

struct Unit { int pm, pn; };
struct Gemm { const bf16_t* A; const bf16_t* Bt; int M, N, K, lda; unsigned* dummy; };

struct StaticOrder {
    int nM, nN, nwg, G, c;
    __host__ __device__ void init(int M, int N, int G_, int c_) { nM = M / BM; nN = N / BM; nwg = nM * nN; G = G_; c = c_; }
    __host__ __device__ bool next(int i, Unit& u) const {
        const long L = (long)i * G + c; if (L >= nwg) return false;
        int wgid = (int)L; { const int q = nwg / NXCD, r = nwg % NXCD, xcd = wgid % NXCD, off = wgid / NXCD; wgid = (xcd < r ? xcd * (q + 1) : r * (q + 1) + (xcd - r) * q) + off; }
        const int nig = WGM * nN, gid = wgid / nig, fm = gid * WGM, gsz = (nM - fm) < WGM ? (nM - fm) : WGM;
        u.pm = fm + ((wgid % nig) % gsz); u.pn = (wgid % nig) / gsz; return true;
    }
    __device__ __forceinline__ void a_ready(const Unit&) const {}
    __device__ __forceinline__ void done(const Unit&) const {}
};

__device__ __forceinline__ unsigned cvt_pk_bf16(float lo, float hi) { unsigned r; asm volatile("v_cvt_pk_bf16_f32 %0, %1, %2" : "=v"(r) : "v"(lo), "v"(hi)); return r; }

struct EpiBf16 {
    static constexpr bool PERM = true, AFTER_DRAIN = false; static constexpr int NSTORE = 16;
    bf16_t* O; int ldc; float* vstat;
    __device__ __forceinline__ void operator()(const f32x4 (&acc)[2][2][4][2], const Unit& u, int wr, int wc, int fr, int fq) const {
        const int row0 = u.pm * BM + wr * 64 + fr; const int col0 = u.pn * BM + wc * 32 + 8 * fq;
        const bool st = vstat != nullptr && u.pn >= 4 && u.pn < 8;
#pragma unroll
        for (int ai = 0; ai < 2; ++ai)
#pragma unroll
            for (int m = 0; m < 4; ++m) { const int row = row0 + ai * HALF + m * 16; bf16_t* rowp = O + (size_t)row * ldc + col0; float s = 0.f, q = 0.f;
#pragma unroll
                for (int bj = 0; bj < 2; ++bj) { const f32x4 v0 = acc[ai][bj][m][0], v1 = acc[ai][bj][m][1];
                    u32x4 w; w.x = cvt_pk_bf16(v0[0], v0[1]); w.y = cvt_pk_bf16(v0[2], v0[3]); w.z = cvt_pk_bf16(v1[0], v1[1]); w.w = cvt_pk_bf16(v1[2], v1[3]);
                    *(u32x4*)(rowp + bj * HALF) = w;
                    s += ((v0[0] + v0[1]) + (v0[2] + v0[3])) + ((v1[0] + v1[1]) + (v1[2] + v1[3]));
                    q += (v0[0] * v0[0] + v0[1] * v0[1]) + (v0[2] * v0[2] + v0[3] * v0[3]) + (v1[0] * v1[0] + v1[1] * v1[1]) + (v1[2] * v1[2] + v1[3] * v1[3]); }
                if (st) { s += __shfl_xor(s, 16); s += __shfl_xor(s, 32); q += __shfl_xor(q, 16); q += __shfl_xor(q, 32);
                    if (fq == 0) { typedef float f32x2v __attribute__((ext_vector_type(2))); *(f32x2v*)(vstat + (size_t)row * 32 + 2 * (4 * (u.pn - 4) + wc)) = (f32x2v){s, q}; } } }
    }
};

struct EpiSame {
    static constexpr bool PERM = true, AFTER_DRAIN = false; static constexpr int NSTORE = 0;
    bf16_t* O; int ldc, fpm, fpn;
    __device__ __forceinline__ void operator()(const f32x4 (&acc)[2][2][4][2], const Unit& u, int wr, int wc, int fr, int fq) const {
        const int row0 = fpm * BM + wr * 64 + fr; const int col0 = fpn * BM + wc * 32 + 8 * fq;
#pragma unroll
        for (int ai = 0; ai < 2; ++ai)
#pragma unroll
            for (int m = 0; m < 4; ++m) { bf16_t* rowp = O + (size_t)(row0 + ai * HALF + m * 16) * ldc + col0;
#pragma unroll
                for (int bj = 0; bj < 2; ++bj) { const f32x4 v0 = acc[ai][bj][m][0], v1 = acc[ai][bj][m][1];
                    u32x4 w; w.x = cvt_pk_bf16(v0[0], v0[1]); w.y = cvt_pk_bf16(v0[2], v0[3]); w.z = cvt_pk_bf16(v1[0], v1[1]); w.w = cvt_pk_bf16(v1[2], v1[3]);
                    *(u32x4*)(rowp + bj * HALF) = w; } }
    }
};
struct EpiNone {
    static constexpr bool PERM = true, AFTER_DRAIN = false; static constexpr int NSTORE = 0;
    __device__ __forceinline__ void operator()(const f32x4 (&acc)[2][2][4][2], const Unit& u, int wr, int wc, int fr, int fq) const {
#pragma unroll
        for (int ai = 0; ai < 2; ++ai)
#pragma unroll
            for (int bj = 0; bj < 2; ++bj)
#pragma unroll
                for (int m = 0; m < 4; ++m)
#pragma unroll
                    for (int n = 0; n < 2; ++n) asm volatile("" :: "v"(acc[ai][bj][m][n]));
    }
};

template <int MODE> struct EpiResid {
    static constexpr bool PERM = true, AFTER_DRAIN = false; static constexpr int NSTORE = 0;
    const float* xold; bf16_t* xbf; float* ssq;
    __device__ __forceinline__ void operator()(const f32x4 (&acc)[2][2][4][2], const Unit& u, int wr, int wc, int fr, int fq) const {
        const int row0 = u.pm * BM + wr * 64 + fr; const int col0 = u.pn * BM + wc * 32 + 8 * fq;
#pragma unroll
        for (int ai = 0; ai < 2; ++ai)
#pragma unroll
            for (int m = 0; m < 4; ++m) { const int row = row0 + ai * HALF + m * 16; const size_t off = (size_t)row * 1024 + col0; float s = 0.f;
#pragma unroll
                for (int bj = 0; bj < 2; ++bj) {
                    f32x4 o0, o1;
                    if (MODE == 0) { o0 = *(const f32x4*)(xold + off + bj * HALF); o1 = *(const f32x4*)(xold + off + bj * HALF + 4); }
                    else { const u32x4 w = *(const u32x4*)(xbf + off + bj * HALF);
                        o0 = (f32x4){__uint_as_float(w.x << 16), __uint_as_float(w.x & 0xffff0000u), __uint_as_float(w.y << 16), __uint_as_float(w.y & 0xffff0000u)};
                        o1 = (f32x4){__uint_as_float(w.z << 16), __uint_as_float(w.z & 0xffff0000u), __uint_as_float(w.w << 16), __uint_as_float(w.w & 0xffff0000u)}; }
                    const f32x4 v0 = o0 + acc[ai][bj][m][0], v1 = o1 + acc[ai][bj][m][1];
                    u32x4 w; w.x = cvt_pk_bf16(v0[0], v0[1]); w.y = cvt_pk_bf16(v0[2], v0[3]); w.z = cvt_pk_bf16(v1[0], v1[1]); w.w = cvt_pk_bf16(v1[2], v1[3]); *(u32x4*)(xbf + off + bj * HALF) = w;
                    s += (v0[0] * v0[0] + v0[1] * v0[1]) + (v0[2] * v0[2] + v0[3] * v0[3]) + (v1[0] * v1[0] + v1[1] * v1[1]) + (v1[2] * v1[2] + v1[3] * v1[3]);
                }
                s += __shfl_xor(s, 16); s += __shfl_xor(s, 32);
                if (fq == 0) ssq[(size_t)row * 16 + u.pn * 4 + wc] = s;
                asm volatile("" ::: "memory"); }
    }
};

template <class Epi, class Sched, bool ALIGN_EPI = false, bool SP2 = false>
__device__ __forceinline__ void gemm_phase(PG8_LAS unsigned char* lds, const Gemm g, const Sched& S, const Epi& E) {
    int tid_ = threadIdx.x; asm volatile("" : "+v"(tid_));
    const int tid = tid_, wid = __builtin_amdgcn_readfirstlane(tid >> 6), lane = tid & 63, wr = wid >> 2, wc = wid & 3, fr = lane & 15, fq = lane >> 4;
    const int K = g.K, nt = K / BK, lda = g.lda;
    unsigned voffA[2], voffB[2];
#pragma unroll
    for (int i = 0; i < 2; ++i) { int R, C; stage_rc(tid * 16 + i * 8192, R, C); const int Rb = Epi::PERM ? ((R & ~31) + perm32(R & 31)) : R;
        voffA[i] = (unsigned)(R * lda + C) * 2u; voffB[i] = (unsigned)(Rb * K + C) * 2u; }
    const size_t kstep = (size_t)(BK * 2);
    const size_t hstepA = (size_t)HALF * lda * 2, hstepB = (size_t)HALF * K * 2;
    const size_t tstepA = 2 * hstepA, tstepB = 2 * hstepB;
    const unsigned ldsw = (unsigned)wid * 1024u;
    const int aoff = lds_byte(wr * 64 + fr, fq * 8), boff = lds_byte(wc * 32 + fr, fq * 8);
#define PG8_SA(b, h) (((b) * 2 + (h)) * HTB)
#define PG8_SB(b, h) ((4 + (b) * 2 + (h)) * HTB)
#define PG8_STAGE(bufoff, gbase, voff) do { _Pragma("unroll") for (int _i = 0; _i < 2; ++_i) \
        __builtin_amdgcn_global_load_lds((const unsigned*)((const char*)(gbase) + (voff)[_i]), (PG8_LAS unsigned*)(lds + (bufoff) + ldsw + _i * 8192), 16, 0, 0); } while (0)
#define PG8_LDA(dst, b, h) do { _Pragma("unroll") for (int m = 0; m < 4; ++m) _Pragma("unroll") for (int k = 0; k < 2; ++k) dst[m][k] = *(const PG8_LAS bf16x8*)(lds + PG8_SA(b, h) + aoff + m * 2048 + k * 1024); } while (0)
#define PG8_LDB(dst, b, h) do { _Pragma("unroll") for (int n = 0; n < 2; ++n) _Pragma("unroll") for (int k = 0; k < 2; ++k) dst[n][k] = *(const PG8_LAS bf16x8*)(lds + PG8_SB(b, h) + boff + n * 2048 + k * 1024); } while (0)
#define PG8_MMA(ai, bj, At, Bt) do { __builtin_amdgcn_s_setprio(1); _Pragma("unroll") for (int m = 0; m < 4; ++m) _Pragma("unroll") for (int n = 0; n < 2; ++n) _Pragma("unroll") for (int k = 0; k < 2; ++k) \
        acc[ai][bj][m][n] = __builtin_amdgcn_mfma_f32_16x16x32_bf16(Bt[n][k], At[m][k], acc[ai][bj][m][n], 0, 0, 0); __builtin_amdgcn_s_setprio(0); } while (0)
#define PG8_WAIT_V(n) asm volatile("s_waitcnt vmcnt(" #n ")" ::: "memory")
#define PG8_WAIT_L(n) asm volatile("s_waitcnt lgkmcnt(" #n ")" ::: "memory")
#define PG8_BAR __builtin_amdgcn_s_barrier()
#define PG8_SCHED __builtin_amdgcn_sched_barrier(0)
    Unit cur, nxt; int ui = 0;
    if (!S.next(0, cur)) return;
    f32x4 acc[2][2][4][2];
#pragma unroll
    for (int a = 0; a < 2; ++a)
#pragma unroll
        for (int b = 0; b < 2; ++b)
#pragma unroll
            for (int m = 0; m < 4; ++m)
#pragma unroll
                for (int n = 0; n < 2; ++n) acc[a][b][m][n] = (f32x4){0.f, 0.f, 0.f, 0.f};
    bf16x8 At[4][2], B0[2][2], B1[2][2];
    const char* cA = (const char*)g.A + (size_t)cur.pm * tstepA; const char* cB = (const char*)g.Bt + (size_t)cur.pn * tstepB;
    S.a_ready(cur);
    if constexpr (SP2) {
        PG8_STAGE(PG8_SB(0, 0), cB, voffB); PG8_STAGE(PG8_SB(0, 1), cB + hstepB, voffB); PG8_STAGE(PG8_SA(0, 0), cA, voffA); PG8_STAGE(PG8_SA(0, 1), cA + hstepA, voffA);
        if (wr == 1) PG8_BAR;
        PG8_WAIT_V(2); PG8_BAR;
        PG8_STAGE(PG8_SB(1, 0), cB + kstep, voffB); PG8_STAGE(PG8_SA(1, 0), cA + kstep, voffA); PG8_STAGE(PG8_SB(1, 1), cB + hstepB + kstep, voffB);
        PG8_WAIT_V(6); PG8_BAR;
        if constexpr (Epi::NSTORE > 0) {
            unsigned* dp = g.dummy + (size_t)blockIdx.x * 512 + tid;
#pragma unroll
            for (int i = 0; i < Epi::NSTORE; ++i) { __builtin_nontemporal_store(0u, dp); asm volatile("" ::: "memory"); }
        }
    } else {
        PG8_STAGE(PG8_SB(0, 0), cB, voffB); PG8_STAGE(PG8_SA(0, 0), cA, voffA); PG8_STAGE(PG8_SB(0, 1), cB + hstepB, voffB); PG8_STAGE(PG8_SA(0, 1), cA + hstepA, voffA);
        if (wr == 1) PG8_BAR;
        PG8_WAIT_V(4); PG8_BAR;
        PG8_STAGE(PG8_SB(1, 0), cB + kstep, voffB); PG8_STAGE(PG8_SA(1, 0), cA + kstep, voffA); PG8_STAGE(PG8_SB(1, 1), cB + hstepB + kstep, voffB);
        PG8_WAIT_V(6); PG8_BAR;
    }
    for (;;) {
        const bool has_next = S.next(ui + 1, nxt);
        const char* nA = has_next ? (const char*)g.A + (size_t)nxt.pm * tstepA : cA; const char* nB = has_next ? (const char*)g.Bt + (size_t)nxt.pn * tstepB : cB;
#define PG8_PTRS(T) const bool last = ((T) == nt - 2); \
            const char* a1 = cA + (size_t)((T) + 1) * kstep; \
            const char* a2 = last ? nA : cA + (size_t)((T) + 2) * kstep; const char* b2 = last ? nB : cB + (size_t)((T) + 2) * kstep; \
            const char* a3 = a2 + kstep; const char* b3 = b2 + kstep; \
            if (last && has_next) S.a_ready(nxt);
        int t = 0;
        if constexpr (SP2 && Epi::NSTORE == 16) {
            PG8_PTRS(0)
            PG8_LDB(B0, 0, 0); PG8_LDB(B1, 0, 1); PG8_SCHED; PG8_LDA(At, 0, 0); PG8_STAGE(PG8_SA(1, 1), a1 + hstepA, voffA);
            PG8_WAIT_V(24);
            PG8_WAIT_L(0); PG8_BAR; PG8_MMA(0, 0, At, B0); PG8_MMA(0, 1, At, B1); PG8_BAR; PG8_SCHED;
            PG8_LDA(At, 0, 1); PG8_STAGE(PG8_SB(0, 0), b2, voffB); PG8_STAGE(PG8_SB(0, 1), b2 + hstepB, voffB); PG8_STAGE(PG8_SA(0, 0), a2, voffA);
            PG8_WAIT_V(24);
            PG8_WAIT_L(0); PG8_BAR; PG8_MMA(1, 0, At, B0); PG8_MMA(1, 1, At, B1); PG8_BAR; PG8_SCHED;
            PG8_LDB(B0, 1, 0); PG8_LDB(B1, 1, 1); PG8_SCHED; PG8_LDA(At, 1, 0); PG8_STAGE(PG8_SA(0, 1), a2 + hstepA, voffA);
            PG8_WAIT_V(8); PG8_WAIT_L(0); PG8_BAR; PG8_MMA(0, 0, At, B0); PG8_MMA(0, 1, At, B1); PG8_BAR; PG8_SCHED;
            PG8_LDA(At, 1, 1); PG8_STAGE(PG8_SB(1, 0), b3, voffB); PG8_STAGE(PG8_SB(1, 1), b3 + hstepB, voffB); PG8_STAGE(PG8_SA(1, 0), a3, voffA);
            PG8_WAIT_V(8); PG8_WAIT_L(0); PG8_BAR; PG8_MMA(1, 0, At, B0); PG8_MMA(1, 1, At, B1); PG8_BAR; PG8_SCHED;
            t = 2;
        }
        for (; t < nt; t += 2) {
            PG8_PTRS(t)
            if constexpr (SP2) {
            PG8_LDB(B0, 0, 0); PG8_LDB(B1, 0, 1); PG8_SCHED; PG8_LDA(At, 0, 0); PG8_STAGE(PG8_SA(1, 1), a1 + hstepA, voffA);
            PG8_WAIT_V(8);
            PG8_WAIT_L(0); PG8_BAR; PG8_MMA(0, 0, At, B0); PG8_MMA(0, 1, At, B1); PG8_BAR; PG8_SCHED;
            PG8_LDA(At, 0, 1); PG8_STAGE(PG8_SB(0, 0), b2, voffB); PG8_STAGE(PG8_SB(0, 1), b2 + hstepB, voffB); PG8_STAGE(PG8_SA(0, 0), a2, voffA);
            PG8_WAIT_V(8);
            PG8_WAIT_L(0); PG8_BAR; PG8_MMA(1, 0, At, B0); PG8_MMA(1, 1, At, B1); PG8_BAR; PG8_SCHED;
            PG8_LDB(B0, 1, 0); PG8_LDB(B1, 1, 1); PG8_SCHED; PG8_LDA(At, 1, 0); PG8_STAGE(PG8_SA(0, 1), a2 + hstepA, voffA);
            PG8_WAIT_V(8); PG8_WAIT_L(0); PG8_BAR; PG8_MMA(0, 0, At, B0); PG8_MMA(0, 1, At, B1); PG8_BAR; PG8_SCHED;
            PG8_LDA(At, 1, 1); PG8_STAGE(PG8_SB(1, 0), b3, voffB); PG8_STAGE(PG8_SB(1, 1), b3 + hstepB, voffB); PG8_STAGE(PG8_SA(1, 0), a3, voffA);
            PG8_WAIT_V(8); PG8_WAIT_L(0); PG8_BAR; PG8_MMA(1, 0, At, B0); PG8_MMA(1, 1, At, B1); PG8_BAR; PG8_SCHED;
            } else {
            PG8_LDB(B0, 0, 0); PG8_SCHED; PG8_LDA(At, 0, 0); PG8_STAGE(PG8_SA(1, 1), a1 + hstepA, voffA);
            PG8_WAIT_L(8); PG8_BAR; PG8_WAIT_L(0); PG8_MMA(0, 0, At, B0); PG8_BAR; PG8_SCHED;
            PG8_LDB(B1, 0, 1); PG8_STAGE(PG8_SB(0, 0), b2, voffB);
            PG8_BAR; PG8_WAIT_L(0); PG8_MMA(0, 1, At, B1); PG8_BAR;
            PG8_LDA(At, 0, 1); PG8_STAGE(PG8_SA(0, 0), a2, voffA);
            PG8_BAR; PG8_WAIT_L(0); PG8_MMA(1, 0, At, B0); PG8_BAR; PG8_SCHED;
            PG8_STAGE(PG8_SB(0, 1), b2 + hstepB, voffB);
            PG8_WAIT_V(6); PG8_BAR; PG8_MMA(1, 1, At, B1); PG8_BAR;
            PG8_LDB(B0, 1, 0); PG8_SCHED; PG8_LDA(At, 1, 0); PG8_STAGE(PG8_SA(0, 1), a2 + hstepA, voffA);
            PG8_WAIT_L(8); PG8_BAR; PG8_WAIT_L(0); PG8_MMA(0, 0, At, B0); PG8_BAR; PG8_SCHED;
            PG8_LDB(B1, 1, 1); PG8_STAGE(PG8_SB(1, 0), b3, voffB);
            PG8_BAR; PG8_WAIT_L(0); PG8_MMA(0, 1, At, B1); PG8_BAR;
            PG8_LDA(At, 1, 1); PG8_STAGE(PG8_SA(1, 0), a3, voffA);
            PG8_BAR; PG8_WAIT_L(0); PG8_MMA(1, 0, At, B0); PG8_BAR; PG8_SCHED;
            PG8_STAGE(PG8_SB(1, 1), b3 + hstepB, voffB);
            PG8_WAIT_V(6); PG8_BAR; PG8_MMA(1, 1, At, B1); PG8_BAR;
            }
        }
#undef PG8_PTRS
        if constexpr (ALIGN_EPI) { if (wr == 0) PG8_BAR; }
        if constexpr (!Epi::AFTER_DRAIN) { E(acc, cur, wr, wc, fr, fq); S.done(cur); }
        if (!has_next) break;
#pragma unroll
        for (int a = 0; a < 2; ++a)
#pragma unroll
            for (int b = 0; b < 2; ++b)
#pragma unroll
                for (int m = 0; m < 4; ++m)
#pragma unroll
                    for (int n = 0; n < 2; ++n) acc[a][b][m][n] = (f32x4){0.f, 0.f, 0.f, 0.f};
        cur = nxt; cA = nA; cB = nB; ++ui;
        if constexpr (ALIGN_EPI) { if (wr == 1) PG8_BAR; }
    }
    PG8_WAIT_V(0);
    if constexpr (!ALIGN_EPI) { if (wr == 0) PG8_BAR; }
    PG8_BAR;
#undef PG8_SA
#undef PG8_SB
#undef PG8_STAGE
#undef PG8_LDA
#undef PG8_LDB
#undef PG8_MMA
#undef PG8_WAIT_V
#undef PG8_WAIT_L
#undef PG8_BAR
#undef PG8_SCHED
}
}

#ifndef PG8_SP2
#define PG8_SP2 true
#endif
#ifndef PG8_ALIGN
#define PG8_ALIGN true
#endif

constexpr int DM = 1024, NPROJ = 5120, DMIX = 2048, DEPTH = 2;
#ifndef LDP_PAD
#define LDP_PAD 0
#endif
constexpr int LDP = NPROJ + LDP_PAD;
constexpr int MP = 32768, MS = 256, MT = MP + MS;
constexpr int NPT = 256, NST = 8, NTILES = NPT + NST;
constexpr int PST = 15, DSEQ = 32, PAST = 4096;
constexpr float EPS = 1e-6f;
constexpr size_t OUT_Y = 0, OUT_SPP = (size_t)MT * DM, OUT_SPS = OUT_SPP + (size_t)DEPTH * 8 * PST * DM, OUT_CV = OUT_SPS + (size_t)DEPTH * 8 * PST * DM, OUT_END = OUT_CV + (size_t)DEPTH * 8 * DSEQ * DM;
constexpr size_t MiB = 1u << 20;
constexpr size_t WS_DUMMY = 1 * MiB;
constexpr size_t WS_W1T = 2 * MiB;
constexpr size_t WS_W2T = 22 * MiB;
constexpr size_t WS_WPT = 30 * MiB;
constexpr size_t WS_WSP = 31 * MiB;
constexpr size_t WS_SSQ = 32 * MiB;
constexpr size_t WS_HS = 35 * MiB;
constexpr size_t WS_XBF = 36 * MiB;
constexpr size_t WS_PROJ = 104 * MiB;
constexpr size_t WS_VST = 440 * MiB;
constexpr size_t WS_END = WS_VST + (size_t)MP * 32 * 4;
static_assert(WS_PROJ + (size_t)MT * LDP * 2 <= WS_VST, "d_ws map");
static_assert(WS_SSQ + (size_t)MT * 16 * 4 <= WS_XBF && WS_XBF + (size_t)MT * DM * 2 <= WS_PROJ, "d_ws map");

constexpr int SC_OFF = 131072;
constexpr int LDS_BYTES = 147456;

#define LAS __attribute__((address_space(3)))
typedef unsigned short bf16_t;
typedef short bf16x8 __attribute__((ext_vector_type(8)));
typedef short s16x4 __attribute__((ext_vector_type(4)));
typedef float f32x4 __attribute__((ext_vector_type(4)));
typedef float f32x2 __attribute__((ext_vector_type(2)));
typedef __bf16 bf16x2_t __attribute__((ext_vector_type(2)));
typedef unsigned u32x4 __attribute__((ext_vector_type(4)));
typedef unsigned u32x2 __attribute__((ext_vector_type(2)));
#define LDS_WAIT() asm volatile("s_waitcnt lgkmcnt(0)" ::: "memory")

__device__ __forceinline__ unsigned pk2(float lo, float hi) { f32x2 v = {lo, hi}; bf16x2_t b = __builtin_convertvector(v, bf16x2_t); return __builtin_bit_cast(unsigned, b); }
__device__ __forceinline__ float bflo(unsigned w) { return __uint_as_float(w << 16); }
__device__ __forceinline__ float bfhi(unsigned w) { return __uint_as_float(w & 0xffff0000u); }
__device__ __forceinline__ float wave_sum(float v) {
#pragma unroll
    for (int o = 1; o < 64; o <<= 1) v += __shfl_xor(v, o);
    return v;
}
__device__ __forceinline__ float silu_f(float z) { return z * __builtin_amdgcn_rcpf(1.0f + __expf(-z)); }
__device__ __forceinline__ float rsqrt_f(float x) { return __builtin_amdgcn_rsqf(x); }
__device__ __forceinline__ void unpack8(const u32x4 w, float (&f)[8]) { f[0] = bflo(w.x); f[1] = bfhi(w.x); f[2] = bflo(w.y); f[3] = bfhi(w.y); f[4] = bflo(w.z); f[5] = bfhi(w.z); f[6] = bflo(w.w); f[7] = bfhi(w.w); }
__device__ __forceinline__ s16x4 vtr(const LAS unsigned char* p) { typedef short v4i16_t __attribute__((ext_vector_type(4))); return __builtin_bit_cast(s16x4, __builtin_amdgcn_ds_read_tr16_b64_v4i16((LAS v4i16_t*)p)); }
__device__ __forceinline__ unsigned off_b(unsigned row, unsigned ch) { return 256u * row + 16u * (ch ^ (((row & 3) << 2) | ((row >> 2) & 3))); }
__device__ __forceinline__ unsigned tr_addr16(unsigned lane, unsigned c, unsigned ks, unsigned t) {
    const unsigned g = lane >> 4, q = (lane & 15) >> 2, p = lane & 3;
    return off_b(32 * ks + 8 * g + 4 * t + q, 2 * c + (p >> 1)) + 8 * (p & 1);
}

__device__ __forceinline__ void p0_transpose_item(const float* W, int K, int N, bf16_t* WT, const float* kscale, LAS float* scr, int item, int lane) {
    const int nblk = N / 32, kb = item / nblk, nb = item % nblk, k0 = 64 * kb, n0 = 32 * nb;
#pragma unroll 8
    for (int i = 0; i < 32; ++i) { const int kk = 2 * i + (lane >> 5); float v = W[(size_t)(k0 + kk) * N + n0 + (lane & 31)]; if (kscale) v *= kscale[k0 + kk]; scr[kk * 33 + (lane & 31)] = v; }
    LDS_WAIT(); asm volatile("" ::: "memory");
    const int c = lane & 7;
#pragma unroll
    for (int j = 0; j < 4; ++j) { const int n = (lane >> 3) + 8 * j; const LAS float* s = scr + (8 * c) * 33 + n;
        u32x4 o; o.x = pk2(s[0 * 33], s[1 * 33]); o.y = pk2(s[2 * 33], s[3 * 33]); o.z = pk2(s[4 * 33], s[5 * 33]); o.w = pk2(s[6 * 33], s[7 * 33]);
        *(u32x4*)(WT + (size_t)(n0 + n) * K + k0 + 8 * c) = o; }
    LDS_WAIT(); asm volatile("" ::: "memory");
}

struct Args { const float* in[13]; float* out; unsigned char* ws; };

__device__ __forceinline__ void p0_prep(const Args& a, LAS unsigned char* lds, int gw, int NGW, int wave) {
    int tl = threadIdx.x; asm volatile("" : "+v"(tl)); const int lane = tl & 63;
    LAS float* scr = (LAS float*)(lds + wave * 16384);
    unsigned char* ws = a.ws;
    constexpr int I1 = (DM / 64) * (NPROJ / 32), I2 = (DMIX / 64) * (DM / 32), I3 = (256 / 64) * (256 / 32);
    constexpr int NITEMS = DEPTH * I1 + DEPTH * I2 + DEPTH * 4 * I3;
    for (int it = gw; it < NITEMS; it += NGW) {
        int r = it;
        if (r < DEPTH * I1) { const int l = r / I1; r -= l * I1; p0_transpose_item(a.in[4] + (size_t)l * DM * NPROJ, DM, NPROJ, (bf16_t*)(ws + WS_W1T) + (size_t)l * NPROJ * DM, a.in[3] + l * DM, scr, r, lane); continue; }
        r -= DEPTH * I1;
        if (r < DEPTH * I2) { const int l = r / I2; r -= l * I2; p0_transpose_item(a.in[11] + (size_t)l * DMIX * DM, DMIX, DM, (bf16_t*)(ws + WS_W2T) + (size_t)l * DM * DMIX, nullptr, scr, r, lane); continue; }
        r -= DEPTH * I2;
        { const int lg = r / I3; r -= lg * I3; p0_transpose_item(a.in[9] + (size_t)lg * 65536, 256, 256, (bf16_t*)(ws + WS_WPT) + (size_t)lg * 65536, nullptr, scr, r, lane); }
    }
    for (int row = gw; row < DEPTH * 8 * 128; row += NGW) {
        const int i = row & 127; const f32x2 v = *(const f32x2*)(a.in[7] + (size_t)row * 128 + 2 * lane);
        const bool keep = ((2 * lane) >> 6) <= (i >> 6);
        ((unsigned*)(ws + WS_WSP))[(size_t)row * 64 + lane] = keep ? pk2(v.x, v.y) : 0u;
    }
    for (int m = gw; m < DEPTH * 8 * PST; m += NGW) {
        const f32x4* xr = (const f32x4*)(a.in[2] + (size_t)m * DM) + lane; u32x2* o8 = (u32x2*)((bf16_t*)(ws + WS_HS) + (size_t)m * DM) + lane;
#pragma unroll
        for (int j = 0; j < 4; ++j) { const f32x4 v = xr[64 * j]; u32x2 w; w.x = pk2(v.x, v.y); w.y = pk2(v.z, v.w); o8[64 * j] = w; }
    }
    for (int m = gw; m < MT; m += NGW) {
        const float* xrow = (m < MP) ? a.in[0] + (size_t)m * DM : a.in[1] + (size_t)(m - MP) * DM;
        const f32x4* xr = (const f32x4*)xrow + lane; f32x4 v[4]; float s = 0.f;
#pragma unroll
        for (int j = 0; j < 4; ++j) { v[j] = xr[64 * j]; s += (v[j].x * v[j].x + v[j].y * v[j].y) + (v[j].z * v[j].z + v[j].w * v[j].w); }
        s = wave_sum(s);
        u32x2* o8 = (u32x2*)((bf16_t*)(ws + WS_XBF) + (size_t)m * DM) + lane;
#pragma unroll
        for (int j = 0; j < 4; ++j) { u32x2 w; w.x = pk2(v[j].x, v[j].y); w.y = pk2(v[j].z, v[j].w); o8[64 * j] = w; }
        if (lane < 16) ((float*)(ws + WS_SSQ))[(size_t)m * 16 + lane] = (lane == 0) ? s : 0.f;
    }
}

template <int MTW, int NTW, int KQ, class Epi>
__device__ __forceinline__ void small_gemm(LAS unsigned char* lds, const bf16_t* A, int lda, int kbreak, int kjump, const bf16_t* Bt, int K, int row_base, int col_base, const Epi& E) {
    int tl = threadIdx.x; asm volatile("" : "+v"(tl));
    const int lane = tl & 63, fr = lane & 15, fq = lane >> 4;
    const int wave = __builtin_amdgcn_readfirstlane(tl >> 6), kq = wave % KQ, mh = wave / KQ;
    const int KS = K / KQ, NKS = KS / 32;
    const int r0 = row_base + 16 * MTW * mh, k0 = KS * kq;
    f32x4 acc[MTW][NTW];
#pragma unroll
    for (int mt = 0; mt < MTW; ++mt)
#pragma unroll
        for (int nt = 0; nt < NTW; ++nt) acc[mt][nt] = (f32x4){0.f, 0.f, 0.f, 0.f};
    const bf16_t* ap = A + (size_t)(r0 + fr) * lda + k0 + (k0 >= kbreak ? kjump : 0) + 8 * fq;
    const bf16_t* bp = Bt + (size_t)(col_base + fr) * K + k0 + 8 * fq;
#pragma unroll 1
    for (int kb = 0; kb < NKS; kb += 4) {
        bf16x8 af[MTW][4], bfm[NTW][4];
#pragma unroll
        for (int mt = 0; mt < MTW; ++mt)
#pragma unroll
            for (int j = 0; j < 4; ++j) af[mt][j] = *(const bf16x8*)(ap + (size_t)(16 * mt) * lda + 32 * (kb + j));
#pragma unroll
        for (int nt = 0; nt < NTW; ++nt)
#pragma unroll
            for (int j = 0; j < 4; ++j) bfm[nt][j] = *(const bf16x8*)(bp + (size_t)(16 * nt) * K + 32 * (kb + j));
        __builtin_amdgcn_sched_barrier(0);
#pragma unroll
        for (int j = 0; j < 4; ++j)
#pragma unroll
            for (int mt = 0; mt < MTW; ++mt)
#pragma unroll
                for (int nt = 0; nt < NTW; ++nt) acc[mt][nt] = __builtin_amdgcn_mfma_f32_16x16x32_bf16(bfm[nt][j], af[mt][j], acc[mt][nt], 0, 0, 0);
        __builtin_amdgcn_sched_barrier(0);
    }
    LAS f32x4* part = (LAS f32x4*)lds;
    if (kq > 0) {
#pragma unroll
        for (int mt = 0; mt < MTW; ++mt)
#pragma unroll
            for (int nt = 0; nt < NTW; ++nt) part[(((mh * (KQ - 1) + (kq - 1)) * MTW + mt) * NTW + nt) * 64 + lane] = acc[mt][nt];
    }
    __syncthreads();
    if (kq == 0) {
#pragma unroll
        for (int q = 0; q < KQ - 1; ++q)
#pragma unroll
            for (int mt = 0; mt < MTW; ++mt)
#pragma unroll
                for (int nt = 0; nt < NTW; ++nt) acc[mt][nt] += part[(((mh * (KQ - 1) + q) * MTW + mt) * NTW + nt) * 64 + lane];
        E(acc, r0, col_base, fr, fq);
    }
    __syncthreads();
}
struct SEpiProj {
    bf16_t* O;
    template <int MTW, int NTW> __device__ __forceinline__ void operator()(const f32x4 (&acc)[MTW][NTW], int r0, int c0, int fr, int fq) const {
#pragma unroll
        for (int mt = 0; mt < MTW; ++mt)
#pragma unroll
            for (int nt = 0; nt < NTW; ++nt) { const f32x4 v = acc[mt][nt]; u32x2 w; w.x = pk2(v[0], v[1]); w.y = pk2(v[2], v[3]);
                *(u32x2*)(O + (size_t)(r0 + 16 * mt + fr) * LDP + c0 + 16 * nt + 4 * fq) = w; }
    }
};
template <int MODE> struct SEpiResid {
    const float* xold; bf16_t* xbf; float* ssq;
    template <int MTW, int NTW> __device__ __forceinline__ void operator()(const f32x4 (&acc)[MTW][NTW], int r0, int c0, int fr, int fq) const {
        static_assert(MTW == 1 && NTW == 4, "SEpiResid: 16 x 64 block");
        const int row = r0 + fr; float s = 0.f;
#pragma unroll
        for (int nt = 0; nt < NTW; ++nt) { const size_t off = (size_t)row * DM + c0 + 16 * nt + 4 * fq; f32x4 o;
            if (MODE == 0) o = *(const f32x4*)(xold + off);
            else { const u32x2 w = *(const u32x2*)(xbf + off); o = (f32x4){bflo(w.x), bfhi(w.x), bflo(w.y), bfhi(w.y)}; }
            const f32x4 v = o + acc[0][nt];
            u32x2 w; w.x = pk2(v[0], v[1]); w.y = pk2(v[2], v[3]); *(u32x2*)(xbf + off) = w;
            s += (v[0] * v[0] + v[1] * v[1]) + (v[2] * v[2] + v[3] * v[3]); }
        s += __shfl_xor(s, 16); s += __shfl_xor(s, 32);
        if (fq == 0) ssq[(size_t)row * 16 + (c0 >> 6)] = s;
    }
};

template <int W>
__device__ __forceinline__ void pool_build(LAS unsigned char* dimg, const LAS float* rr, const bf16_t* mb, const bf16_t* hb, int hp, int g, int tid, int ntok, int pos0) {
    constexpr int NR = W + 7;
    const int seg = tid >> 5, chk = tid & 31, t0 = 8 * seg, cb = 256 * g + 8 * chk;
    const LAS float* rq = rr + (t0 - (W - 1) + 15);
    u32x4 raw[NR];
#pragma unroll
    for (int k = 0; k < NR; ++k) {
        const int t = t0 - (W - 1) + k, tc = t < ntok ? t : ntok - 1;
        const bf16_t* p = (t >= 0) ? mb + (size_t)tc * LDP + cb : hb + (size_t)(PST + t) * hp + cb;
        raw[k] = *(const u32x4*)p;
    }
    float s[8];
#pragma unroll
    for (int e = 0; e < 8; ++e) s[e] = 0.f;
#pragma unroll
    for (int k = 0; k < W - 1; ++k) { float f[8]; unpack8(raw[k], f); const float r = rq[k];
#pragma unroll
        for (int e = 0; e < 8; ++e) s[e] += f[e] * r; }
#pragma unroll
    for (int i = 0; i < 8; ++i) {
        const int t = t0 + i; float cur[8]; unpack8(raw[i + W - 1], cur); const float rc = rq[i + W - 1];
#pragma unroll
        for (int e = 0; e < 8; ++e) { cur[e] *= rc; s[e] += cur[e]; }
        const int cnt = (pos0 + t + 1 < W) ? (pos0 + t + 1) : W; const float inv = 1.0f / (float)cnt;
        u32x4 o; o.x = pk2(s[0] * inv - cur[0], s[1] * inv - cur[1]); o.y = pk2(s[2] * inv - cur[2], s[3] * inv - cur[3]);
        o.z = pk2(s[4] * inv - cur[4], s[5] * inv - cur[5]); o.w = pk2(s[6] * inv - cur[6], s[7] * inv - cur[7]);
        *(LAS u32x4*)(dimg + 512 * t + 16 * (chk ^ (t & 15))) = o;
        u32x4 ro = raw[i]; asm volatile("" : "+v"(ro.x), "+v"(ro.y), "+v"(ro.z), "+v"(ro.w));
        float old[8]; unpack8(ro, old); const float r0 = rq[i];
#pragma unroll
        for (int e = 0; e < 8; ++e) s[e] -= old[e] * r0;
    }
}

__device__ __forceinline__ void mixer_tile(const Args& a, LAS unsigned char* lds, int tid_in, int wave, int layer, int tile, int h_lo, int h_hi, int g_lo, int g_hi, bool dry = false) {
    int tid = tid_in; asm volatile("" : "+v"(tid));
    const int lane = tid & 63;
    unsigned char* ws = a.ws;
    bf16_t* proj = (bf16_t*)(ws + WS_PROJ);
    const float* ssq = (const float*)(ws + WS_SSQ);
    const bool samp = tile >= NPT; const int S = tile - NPT;
    const int row0 = samp ? MP + DSEQ * S : tile * 128;
    const int ntok = samp ? DSEQ : 128;
    const int pos0 = samp ? PAST : (tile & 31) * 128;
    const bool has_prev = samp || (tile & 31) != 0;
    const bf16_t* hs = (const bf16_t*)(ws + WS_HS) + ((size_t)layer * 8 + (samp ? S : 0)) * PST * DM;
    const float* ln_g = a.in[5] + layer * DM; const float* ln_b = a.in[6] + layer * DM;
    const bf16_t* wsp = (const bf16_t*)(ws + WS_WSP) + (size_t)layer * 8 * 16384;
    const float* b_sp = a.in[8] + layer * 8 * 128;
    const bf16_t* wpt = (const bf16_t*)(ws + WS_WPT) + (size_t)layer * 4 * 65536;
    const float* pscale = a.in[10] + layer * DM;
    LAS float* rr = (LAS float*)(lds + SC_OFF); LAS float* mu = rr + 144; LAS float* sv = mu + 128;
    const int fr = lane & 15, fq = lane >> 4;

    if (tid < 143) {
        const int t = tid - 15; float r = 0.f;
        const bool from_rows = (t >= 0) ? (t < ntok) : (!samp && has_prev);
        if (from_rows) { const f32x4* p = (const f32x4*)(ssq + (size_t)(row0 + t) * 16); const f32x4 x0 = p[0], x1 = p[1], x2 = p[2], x3 = p[3];
            const float s = ((x0.x + x0.y) + (x0.z + x0.w)) + ((x1.x + x1.y) + (x1.z + x1.w)) + ((x2.x + x2.y) + (x2.z + x2.w)) + ((x3.x + x3.y) + (x3.z + x3.w));
            r = rsqrt_f(s * (1.0f / DM) + EPS); }
        else if (t < 0 && samp) r = 1.f;
        rr[tid] = r;
    }
    __syncthreads();
    if (h_hi > h_lo) {
        if (!samp) {
            if (tid < 128) { const f32x4* p = (const f32x4*)((const float*)(ws + WS_VST) + (size_t)(row0 + tid) * 32); float s = 0.f, q = 0.f;
#pragma unroll
                for (int j = 0; j < 8; ++j) { const f32x4 x = p[j]; s += x.x + x.z; q += x.y + x.w; }
                const float m = s * (1.0f / DM); float var = q * (1.0f / DM) - m * m; var = var > 0.f ? var : 0.f; const float r = rr[tid + 15];
                mu[tid] = m; sv[tid] = r * rsqrt_f(r * r * var + EPS); }
        } else {
#pragma unroll 1
            for (int i0 = 0; i0 < 16; i0 += 4) {
                const int tb = 16 * wave + i0; if (tb >= ntok) break;
                u32x4 ra[4], rb[4];
#pragma unroll
                for (int i = 0; i < 4; ++i) { const u32x4* p = (const u32x4*)(proj + (size_t)(row0 + tb + i) * LDP + 1024); ra[i] = p[lane]; rb[i] = p[lane + 64]; }
#pragma unroll
                for (int i = 0; i < 4; ++i) { float f[8], s = 0.f, q = 0.f; unpack8(ra[i], f);
#pragma unroll
                    for (int e = 0; e < 8; ++e) { s += f[e]; q += f[e] * f[e]; }
                    unpack8(rb[i], f);
#pragma unroll
                    for (int e = 0; e < 8; ++e) { s += f[e]; q += f[e] * f[e]; }
                    s = wave_sum(s); q = wave_sum(q);
                    const float m = s * (1.0f / DM); float var = q * (1.0f / DM) - m * m; var = var > 0.f ? var : 0.f; const float r = rr[tb + i + 15];
                    if (lane == 0) { mu[tb + i] = m; sv[tb + i] = r * rsqrt_f(r * r * var + EPS); } }
            }
        }
        __syncthreads();
    }
    if (h_hi > h_lo) {
        const int ch8 = tid & 15, tk0 = tid >> 4;
        const int Gw = ch8 >> 2, q8 = ch8 & 3;
        const int wi = wave & 3, wc2 = wave >> 2, it0 = wi, it1 = 7 - wi;
        u32x4 raw[4], uu[2][2], zz[2][2];
#pragma unroll
        for (int i = 0; i < 4; ++i) { const int tok = tk0 + 32 * i, tc = tok < ntok ? tok : ntok - 1; raw[i] = *(const u32x4*)(proj + (size_t)(row0 + tc) * LDP + 1024 + 128 * h_lo + 8 * ch8); }
#pragma unroll
        for (int sel = 0; sel < 2; ++sel) { const int i = 16 * (sel ? it1 : it0) + fr;
#pragma unroll
            for (int G2 = 0; G2 < 2; ++G2) { const bf16_t* pu = proj + (size_t)(row0 + (i < ntok ? i : ntok - 1)) * LDP + 128 * h_lo + 32 * (2 * wc2 + G2) + 8 * fq; uu[sel][G2] = *(const u32x4*)pu; zz[sel][G2] = *(const u32x4*)(pu + 2048); } }
#pragma unroll 1
        for (int h = h_lo; h < h_hi; ++h) {
            LAS unsigned char* img = lds + (h & 1) * 32768;
            { const f32x4 g0 = *(const f32x4*)(ln_g + 128 * h + 8 * ch8), g1 = *(const f32x4*)(ln_g + 128 * h + 8 * ch8 + 4);
              const f32x4 b0 = *(const f32x4*)(ln_b + 128 * h + 8 * ch8), b1 = *(const f32x4*)(ln_b + 128 * h + 8 * ch8 + 4);
#pragma unroll
              for (int i = 0; i < 4; ++i) { const int tok = tk0 + 32 * i; float f[8]; unpack8(raw[i], f);
                  float m = 0.f, sc = 0.f; if (tok < ntok) { m = mu[tok]; sc = sv[tok]; }
                  f32x4 y0, y1;
                  y0.x = (f[0] - m) * sc * g0.x + b0.x; y0.y = (f[1] - m) * sc * g0.y + b0.y; y0.z = (f[2] - m) * sc * g0.z + b0.z; y0.w = (f[3] - m) * sc * g0.w + b0.w;
                  y1.x = (f[4] - m) * sc * g1.x + b1.x; y1.y = (f[5] - m) * sc * g1.y + b1.y; y1.z = (f[6] - m) * sc * g1.z + b1.z; y1.w = (f[7] - m) * sc * g1.w + b1.w;
                  if (tok >= ntok) { y0 = (f32x4){0.f, 0.f, 0.f, 0.f}; y1 = y0; }
                  u32x2 p0, p1; p0.x = pk2(y0.x, y0.y); p0.y = pk2(y0.z, y0.w); p1.x = pk2(y1.x, y1.y); p1.y = pk2(y1.z, y1.w);
                  *(LAS u32x2*)(img + off_b(tok, 4 * Gw + (q8 >> 1)) + 8 * (q8 & 1)) = p0;
                  *(LAS u32x2*)(img + off_b(tok, 4 * Gw + 2 + (q8 >> 1)) + 8 * (q8 & 1)) = p1;
                  if (samp && tok < ntok) { float* cv = a.out + OUT_CV + (((size_t)layer * 8 + S) * DSEQ + tok) * DM + 128 * h + 8 * ch8; *(f32x4*)cv = y0; *(f32x4*)(cv + 4) = y1; }
              } }
            u32x4 un[2][2], zn[2][2];
            { const int hn = (h + 1 < h_hi) ? h + 1 : h;
#pragma unroll
                for (int i = 0; i < 4; ++i) { const int tok = tk0 + 32 * i, tc = tok < ntok ? tok : ntok - 1; raw[i] = *(const u32x4*)(proj + (size_t)(row0 + tc) * LDP + 1024 + 128 * hn + 8 * ch8); }
#pragma unroll
                for (int sel = 0; sel < 2; ++sel) { const int i = 16 * (sel ? it1 : it0) + fr;
#pragma unroll
                    for (int G2 = 0; G2 < 2; ++G2) { const bf16_t* pu = proj + (size_t)(row0 + (i < ntok ? i : ntok - 1)) * LDP + 128 * hn + 32 * (2 * wc2 + G2) + 8 * fq; un[sel][G2] = *(const u32x4*)pu; zn[sel][G2] = *(const u32x4*)(pu + 2048); } }
            }
            const bf16_t* wh = wsp + h * 16384;
            bf16x8 w0[2], w1[4];
#pragma unroll
            for (int ks = 0; ks < 2; ++ks) w0[ks] = *(const bf16x8*)(wh + (16 * it0 + fr) * 128 + 32 * ks + 8 * fq);
#pragma unroll
            for (int ks = 0; ks < 4; ++ks) w1[ks] = *(const bf16x8*)(wh + (16 * it1 + fr) * 128 + 32 * ks + 8 * fq);
            __syncthreads();
            f32x4 acc[2][2][2];
#pragma unroll
            for (int G2 = 0; G2 < 2; ++G2)
#pragma unroll
                for (int n = 0; n < 2; ++n) { const int c = 2 * (2 * wc2 + G2) + n; f32x4 a0 = (f32x4){0.f, 0.f, 0.f, 0.f}, a1 = a0;
#pragma unroll
                    for (int ks = 0; ks < 4; ++ks) {
                        const s16x4 lo = vtr(img + tr_addr16(lane, c, ks, 0)), hi = vtr(img + tr_addr16(lane, c, ks, 1));
                        const bf16x8 af = (bf16x8){lo[0], lo[1], lo[2], lo[3], hi[0], hi[1], hi[2], hi[3]};
                        if (ks < 2) a0 = __builtin_amdgcn_mfma_f32_16x16x32_bf16(af, w0[ks], a0, 0, 0, 0);
                        a1 = __builtin_amdgcn_mfma_f32_16x16x32_bf16(af, w1[ks], a1, 0, 0, 0);
                    }
                    acc[G2][n][0] = a0; acc[G2][n][1] = a1; }
#pragma unroll
            for (int sel = 0; sel < 2; ++sel) { const int i = 16 * (sel ? it1 : it0) + fr;
                if (i < ntok) { const float r = rr[i + 15], bs = b_sp[h * 128 + i];
#pragma unroll
                    for (int G2 = 0; G2 < 2; ++G2) { float fu[8], fz[8], o[8]; unpack8(uu[sel][G2], fu); unpack8(zz[sel][G2], fz);
#pragma unroll
                        for (int e = 0; e < 8; ++e) { const float gate = acc[G2][e >> 2][sel][e & 3] + bs; o[e] = (r * fu[e]) * gate * silu_f(r * fz[e]); }
                        u32x4 w; w.x = pk2(o[0], o[1]); w.y = pk2(o[2], o[3]); w.z = pk2(o[4], o[5]); w.w = pk2(o[6], o[7]);
                        if (!dry) *(u32x4*)(proj + (size_t)(row0 + i) * LDP + 128 * h + 32 * (2 * wc2 + G2) + 8 * fq) = w; else asm volatile("" :: "v"(w)); } } }
#pragma unroll
            for (int sel = 0; sel < 2; ++sel)
#pragma unroll
                for (int G2 = 0; G2 < 2; ++G2) { uu[sel][G2] = un[sel][G2]; zz[sel][G2] = zn[sel][G2]; }
        }
    }
    __syncthreads();
    if (g_lo == 0 && g_hi > 0 && (samp || (tile & 31) == 31)) {
        const int tfirst = ntok - PST;
        float* so = samp ? a.out + OUT_SPS + ((size_t)layer * 8 + S) * PST * DM : a.out + OUT_SPP + ((size_t)layer * 8 + (tile >> 5)) * PST * DM;
        for (int q = tid; q < PST * 128; q += 512) { const int s = q >> 7, ch = q & 127, t = tfirst + s; const float r = rr[t + 15];
            const u32x4 w = *(const u32x4*)(proj + (size_t)(row0 + t) * LDP + 3072 + 8 * ch); float f[8]; unpack8(w, f);
            *(f32x4*)(so + (size_t)s * DM + 8 * ch) = (f32x4){f[0] * r, f[1] * r, f[2] * r, f[3] * r}; *(f32x4*)(so + (size_t)s * DM + 8 * ch + 4) = (f32x4){f[4] * r, f[5] * r, f[6] * r, f[7] * r}; }
    }
    {
#pragma unroll 1
        for (int g = g_lo; g < g_hi; ++g) {
            LAS unsigned char* dimg = lds + (g & 1) * 65536;
            int tl = tid; asm volatile("" : "+v"(tl));
            const int lfr = tl & 15, lfq = (tl >> 4) & 3;
            const bf16_t* wg = wpt + (size_t)g * 65536;
            bf16x8 afr[2][8];
#pragma unroll
            for (int n = 0; n < 2; ++n) { const int dout = 32 * wave + 8 * (lfr >> 2) + 4 * n + (lfr & 3);
#pragma unroll
                for (int ks = 0; ks < 8; ++ks) afr[n][ks] = *(const bf16x8*)(wg + dout * 256 + 32 * ks + 8 * lfq); }
            const bf16_t* mb = proj + (size_t)row0 * LDP + 3072;
            const bf16_t* hb = samp ? hs : (has_prev ? mb - (size_t)PST * LDP : mb); const int hp = samp ? DM : (has_prev ? LDP : 0);
            if (g == 0) pool_build<2>(dimg, rr, mb, hb, hp, g, tl, ntok, pos0);
            else if (g == 1) pool_build<4>(dimg, rr, mb, hb, hp, g, tl, ntok, pos0);
            else if (g == 2) pool_build<8>(dimg, rr, mb, hb, hp, g, tl, ntok, pos0);
            else pool_build<16>(dimg, rr, mb, hb, hp, g, tl, ntok, pos0);
            __syncthreads();
            const int d8 = 256 * g + 32 * wave + 8 * lfq;
            u32x4 zw[8];
#pragma unroll
            for (int tt = 0; tt < 8; ++tt) { const int i = 16 * tt + lfr; zw[tt] = *(const u32x4*)(proj + (size_t)(row0 + (i < ntok ? i : ntok - 1)) * LDP + 4096 + d8); }
            f32x4 acc[2][8];
#pragma unroll
            for (int n = 0; n < 2; ++n)
#pragma unroll
                for (int tt = 0; tt < 8; ++tt) acc[n][tt] = (f32x4){0.f, 0.f, 0.f, 0.f};
#pragma unroll
            for (int ks = 0; ks < 8; ++ks) {
#pragma unroll
                for (int tt = 0; tt < 8; ++tt) { const bf16x8 bfr = *(const LAS bf16x8*)(dimg + 512 * (16 * tt + lfr) + 16 * ((4 * ks + lfq) ^ lfr));
                    acc[0][tt] = __builtin_amdgcn_mfma_f32_16x16x32_bf16(afr[0][ks], bfr, acc[0][tt], 0, 0, 0);
                    acc[1][tt] = __builtin_amdgcn_mfma_f32_16x16x32_bf16(afr[1][ks], bfr, acc[1][tt], 0, 0, 0); }
            }
            const f32x4 s0 = *(const f32x4*)(pscale + d8), s1 = *(const f32x4*)(pscale + d8 + 4);
            const float sc[8] = {s0.x, s0.y, s0.z, s0.w, s1.x, s1.y, s1.z, s1.w};
#pragma unroll
            for (int tt = 0; tt < 8; ++tt) { const int i = 16 * tt + lfr;
                if (i < ntok) { const float r = rr[i + 15]; float fz[8], o[8]; unpack8(zw[tt], fz);
#pragma unroll
                    for (int e = 0; e < 8; ++e) o[e] = acc[e >> 2][tt][e & 3] * sc[e] * silu_f(r * fz[e]);
                    u32x4 w; w.x = pk2(o[0], o[1]); w.y = pk2(o[2], o[3]); w.z = pk2(o[4], o[5]); w.w = pk2(o[6], o[7]);
                    if (!dry) *(u32x4*)(proj + (size_t)(row0 + i) * LDP + (samp ? 4096 : 1024) + d8) = w; else asm volatile("" :: "v"(w)); } }
        }
    }
    __syncthreads();
}

__device__ __forceinline__ void final_norm(const Args& a, int gw, int NGW) {
    int tl = threadIdx.x; asm volatile("" : "+v"(tl)); const int lane = tl & 63;
    const float* ssq = (const float*)(a.ws + WS_SSQ); const float* fg = a.in[12]; const bf16_t* xb = (const bf16_t*)(a.ws + WS_XBF);
    f32x4 gv[2][2];
#pragma unroll
    for (int j = 0; j < 2; ++j) { gv[j][0] = *(const f32x4*)(fg + 8 * (lane + 64 * j)); gv[j][1] = *(const f32x4*)(fg + 8 * (lane + 64 * j) + 4); }
#pragma unroll 2
    for (int m = gw; m < MT; m += NGW) {
        float s = (lane < 16) ? ssq[(size_t)m * 16 + lane] : 0.f; s = wave_sum(s);
        const float r = rsqrt_f(s * (1.0f / DM) + EPS);
        const u32x4* xr = (const u32x4*)(xb + (size_t)m * DM); float* yr = a.out + OUT_Y + (size_t)m * DM;
#pragma unroll
        for (int j = 0; j < 2; ++j) { const u32x4 w = xr[lane + 64 * j]; float f[8]; unpack8(w, f);
            *(f32x4*)(yr + 8 * (lane + 64 * j)) = (f32x4){f[0], f[1], f[2], f[3]} * r * gv[j][0];
            *(f32x4*)(yr + 8 * (lane + 64 * j) + 4) = (f32x4){f[4], f[5], f[6], f[7]} * r * gv[j][1]; }
    }
}

constexpr size_t WS_CTL = 0, CTL_ZERO_BYTES = 65536;
constexpr int BAR_ST_OFF = SC_OFF + 4096;
#define XB_TMO      128
#define XB_XCNT(j)  (256  + 64 * (j))
#define XB_XSUB(j)  (1280 + 64 * (j))
#define XB_XGEN(j)  (2304 + 64 * (j))
#define XB_TOP      3328
#define XB_TOPGEN   3392
#define XCD_BAR_WORDS 3456
#define XB_SPIN_CAP (1u << 18)

__device__ __forceinline__ unsigned xb_ld(unsigned* p)              { return __hip_atomic_load(p, __ATOMIC_RELAXED, __HIP_MEMORY_SCOPE_AGENT); }
__device__ __forceinline__ unsigned xb_add(unsigned* p, unsigned v) { return __hip_atomic_fetch_add(p, v, __ATOMIC_RELAXED, __HIP_MEMORY_SCOPE_AGENT); }
__device__ __forceinline__ unsigned xb_xcc_id() { return (unsigned)__builtin_amdgcn_s_getreg((3 << 11) | 20) & 0xFu; }
#define XB_SPIN(cond, bar) do { unsigned _sp = 0; while (cond) { __builtin_amdgcn_s_sleep(1); \
    if ((++_sp & 255u) == 0u) { if (xb_ld(&(bar)[XB_TMO])) break; if (_sp > XB_SPIN_CAP) { atomicAdd(&(bar)[XB_TMO], 1u); break; } } } } while (0)

struct XcdBarrier {
    unsigned* bar; unsigned x;
    volatile LAS unsigned* st;
};

__device__ __forceinline__ XcdBarrier xcd_barrier_post(unsigned* bar, volatile LAS unsigned* st) {
    XcdBarrier b; b.bar = bar; b.x = xb_xcc_id(); b.st = st;
    if (threadIdx.x == 0) (void)xb_add(&bar[XB_XCNT(b.x)], 1u);
    return b;
}
__device__ __forceinline__ void xcd_barrier_complete(unsigned* bar, unsigned x, unsigned& nloc, unsigned& nx) {
    const unsigned G = gridDim.x * gridDim.y * gridDim.z;
    unsigned sum, cnt, mine, sp = 0u;
    for (;;) {
        sum = 0u; cnt = 0u; mine = 0u;
#pragma unroll
        for (unsigned j = 0; j < 16; ++j) { const unsigned c = xb_ld(&bar[XB_XCNT(j)]); sum += c; cnt += (c > 0u) ? 1u : 0u; mine = (j == x) ? c : mine; }
        if (sum == G) break;
        __builtin_amdgcn_s_sleep(1);
        if ((++sp & 255u) == 0u) { if (xb_ld(&bar[XB_TMO])) break; if (sp > XB_SPIN_CAP) { atomicAdd(&bar[XB_TMO], 1u); break; } }
    }
    nloc = mine > 0u ? mine : 1u; nx = cnt > 0u ? cnt : 1u;
}

__device__ __forceinline__ void xcd_barrier(const XcdBarrier& b) {
    asm volatile("s_waitcnt vmcnt(0)" ::: "memory");
    __syncthreads();
    if (threadIdx.x == 0) {
        unsigned* bar = b.bar;
        __builtin_amdgcn_s_waitcnt(0);
        unsigned nloc = b.st[0], nx = b.st[1];
        if (nloc == 0u) { xcd_barrier_complete(bar, b.x, nloc, nx); b.st[0] = nloc; b.st[1] = nx; }
        const unsigned old = xb_add(&bar[XB_XSUB(b.x)], 1u);
        const unsigned gen = old / nloc;
        if (old + 1u == (gen + 1u) * nloc) {
            __builtin_amdgcn_fence(__ATOMIC_RELEASE, "agent");
            asm volatile("s_waitcnt vmcnt(0)" ::: "memory");
            const unsigned og = xb_add(&bar[XB_TOP], 1u);
            const unsigned tg = og / nx;
            if (og + 1u == (tg + 1u) * nx) xb_add(&bar[XB_TOPGEN], 1u);
            else XB_SPIN(xb_ld(&bar[XB_TOPGEN]) == tg, bar);
            __builtin_amdgcn_fence(__ATOMIC_ACQUIRE, "agent");
            xb_add(&bar[XB_XGEN(b.x)], 1u);
            asm volatile("s_waitcnt vmcnt(0)" ::: "memory");
        } else {
            XB_SPIN(xb_ld(&bar[XB_XGEN(b.x)]) == gen, bar);
            __builtin_amdgcn_fence(__ATOMIC_ACQUIRE, "agent");
            asm volatile("s_waitcnt vmcnt(0)" ::: "memory");
        }
    }
    __syncthreads();
}

constexpr int N_PHASES = 8;
#ifndef MK_PROG
#define MK_PROG {0, 1, 2, 3, 4, 5, 6, 7}
#endif
struct KArgs { Args a; int nprog; int prog[15]; };
template <int COOP>
__global__ void __launch_bounds__(512, 2) fwd_kernel(KArgs ka) {
    extern __shared__ __attribute__((aligned(16))) unsigned char lds_raw[];
    LAS unsigned char* lds = (LAS unsigned char*)lds_raw;
    const Args& a = ka.a;
    const int wave = __builtin_amdgcn_readfirstlane(threadIdx.x >> 6);
    const int G = gridDim.x, bx = blockIdx.x;
    const int vcu = (G % 8 == 0) ? (bx % 8) * (G / 8) + bx / 8 : bx;
    const int gw = vcu * 8 + wave, NGW = G * 8;
    unsigned char* ws = a.ws;
    XcdBarrier bar; bar.bar = nullptr; bar.x = 0; bar.st = nullptr;
    if (COOP == 2) {
        volatile LAS unsigned* st = (volatile LAS unsigned*)(lds + BAR_ST_OFF);
        if (threadIdx.x < 2) st[threadIdx.x] = 0u;
        __syncthreads();
        bar = xcd_barrier_post((unsigned*)(ws + WS_CTL), st);
    }
#pragma unroll 1
    for (int pi = 0; pi < ka.nprog; ++pi) {
        const int ph = ka.prog[pi];
        if (ph == 0) { p0_prep(a, lds, gw, NGW, wave); __syncthreads(); }
        else if (ph == 7) final_norm(a, gw, NGW);
        else if (ph == 8) { }
#ifdef MK_PROBES
        else if (ph == 9) {
            pg8::Gemm g{(const bf16_t*)(ws + WS_XBF), (const bf16_t*)(ws + WS_W1T), MP, NPROJ, DM, DM, (unsigned*)(ws + WS_DUMMY)};
            pg8::StaticOrder S; S.init(MP, NPROJ, G, bx); pg8::EpiNone E;
            pg8::gemm_phase<pg8::EpiNone, pg8::StaticOrder, PG8_ALIGN, PG8_SP2>(lds, g, S, E);
        }
        else if (ph == 11) { for (int tile = bx; tile < NPT; tile += G) mixer_tile(a, lds, threadIdx.x, wave, 0, tile, 0, 8, 0, 0, true); }
        else if (ph == 12) { for (int tile = bx; tile < NPT; tile += G) mixer_tile(a, lds, threadIdx.x, wave, 0, tile, 0, 0, 0, 4, true); }
        else if (ph == 10) {
            pg8::Gemm g{(const bf16_t*)(ws + WS_XBF), (const bf16_t*)(ws + WS_W1T), MP, NPROJ, DM, DM, (unsigned*)(ws + WS_DUMMY)};
            pg8::StaticOrder S; S.init(MP, NPROJ, G, bx); pg8::EpiSame E{(bf16_t*)(ws + WS_PROJ), LDP, bx & 127, bx >> 7};
            pg8::gemm_phase<pg8::EpiSame, pg8::StaticOrder, PG8_ALIGN, PG8_SP2>(lds, g, S, E);
        }
#endif
        else if (ph >= 13) { }
        else {
            const int layer = (ph - 1) / 3, kind = (ph - 1) % 3;
            if (kind == 0) {
                const bf16_t* w1t = (const bf16_t*)(ws + WS_W1T) + (size_t)layer * NPROJ * DM;
                pg8::Gemm g{(const bf16_t*)(ws + WS_XBF), w1t, MP, NPROJ, DM, DM, (unsigned*)(ws + WS_DUMMY)};
                pg8::StaticOrder S; S.init(MP, NPROJ, G, bx);
                pg8::EpiBf16 E{(bf16_t*)(ws + WS_PROJ), LDP, (float*)(ws + WS_VST)};
                pg8::gemm_phase<pg8::EpiBf16, pg8::StaticOrder, PG8_ALIGN, PG8_SP2>(lds, g, S, E);
                SEpiProj SE{(bf16_t*)(ws + WS_PROJ)};
                for (int it = bx; it < 256; it += G) small_gemm<2, 5, 4>(lds, (const bf16_t*)(ws + WS_XBF), DM, 1 << 30, 0, w1t, DM, MP + 64 * (it & 3), 80 * (it >> 2), SE);
            } else if (kind == 1) {
                for (int tile = bx; tile < NPT; tile += G) mixer_tile(a, lds, threadIdx.x, wave, layer, tile, 0, 8, 0, 4);
                for (int it = bx; it < NST * 12; it += G) { const int S = it / 12, part = it % 12;
                    if (part < 8) mixer_tile(a, lds, threadIdx.x, wave, layer, NPT + S, part, part + 1, 0, 0);
                    else mixer_tile(a, lds, threadIdx.x, wave, layer, NPT + S, 0, 0, part - 8, part - 7); }
            } else {
                const bf16_t* w2t = (const bf16_t*)(ws + WS_W2T) + (size_t)layer * DM * DMIX;
                pg8::Gemm g{(const bf16_t*)(ws + WS_PROJ), w2t, MP, DM, DMIX, LDP, (unsigned*)(ws + WS_DUMMY)};
                pg8::StaticOrder S; S.init(MP, DM, G, bx);
                bf16_t* xbf = (bf16_t*)(ws + WS_XBF); float* ssq = (float*)(ws + WS_SSQ);
                if (layer == 0) {
                    pg8::EpiResid<0> E{a.in[0], xbf, ssq}; SEpiResid<0> SE{a.in[1] - (size_t)MP * DM, xbf, ssq};
                    pg8::gemm_phase<pg8::EpiResid<0>, pg8::StaticOrder, PG8_ALIGN, PG8_SP2>(lds, g, S, E);
                    for (int it = bx; it < 256; it += G) small_gemm<1, 4, 8>(lds, (const bf16_t*)(ws + WS_PROJ), LDP, 1024, 3072, w2t, DMIX, MP + 16 * (it & 15), 64 * (it >> 4), SE);
                } else {
                    pg8::EpiResid<1> E{nullptr, xbf, ssq}; SEpiResid<1> SE{nullptr, xbf, ssq};
                    pg8::gemm_phase<pg8::EpiResid<1>, pg8::StaticOrder, PG8_ALIGN, PG8_SP2>(lds, g, S, E);
                    for (int it = bx; it < 256; it += G) small_gemm<1, 4, 8>(lds, (const bf16_t*)(ws + WS_PROJ), LDP, 1024, 3072, w2t, DMIX, MP + 16 * (it & 15), 64 * (it >> 4), SE);
                }
            }
        }
        if (pi + 1 < ka.nprog) { if (COOP == 1) cg::this_grid().sync(); else if (COOP == 2) xcd_barrier(bar); }
    }
}

extern "C" void kernel_launch(void* const* d_in, const int* in_sizes, int n_in, void* d_out, int out_size, void* d_ws, size_t ws_size, hipStream_t stream) {
    static int grid = 0;
    if (grid == 0) {
        if (n_in != 13 || in_sizes[0] != MP * DM || (size_t)out_size != OUT_END || ws_size < WS_END) {
            fprintf(stderr, "kernel_launch: unexpected shapes: n_in %d in0 %d out %d ws %zu (need %zu); nothing launched\n", n_in, n_in > 0 ? in_sizes[0] : -1, out_size, ws_size, (size_t)WS_END); grid = -1; return; }
        int dev = 0, cus = 0, per_cu = 0;
        (void)hipGetDevice(&dev); (void)hipDeviceGetAttribute(&cus, hipDeviceAttributeMultiprocessorCount, dev);
        (void)hipFuncSetAttribute((const void*)fwd_kernel<MK_COOP>, hipFuncAttributeMaxDynamicSharedMemorySize, LDS_BYTES);
        (void)hipOccupancyMaxActiveBlocksPerMultiprocessor(&per_cu, (const void*)fwd_kernel<MK_COOP>, 512, LDS_BYTES);
        (void)hipGetLastError();
        if (per_cu < 1) { fprintf(stderr, "kernel_launch: occupancy query says %d blocks per CU\n", per_cu); per_cu = 1; }
        grid = cus * 1;
    }
    if (grid < 0) return;
    KArgs ka{};
    for (int i = 0; i < 13; ++i) ka.a.in[i] = (const float*)d_in[i];
    ka.a.out = (float*)d_out; ka.a.ws = (unsigned char*)d_ws;
    const int prog[] = MK_PROG; const int np = (int)(sizeof(prog) / sizeof(prog[0]));
#if MK_COOP == 1
    ka.nprog = np; for (int i = 0; i < np; ++i) ka.prog[i] = prog[i];
    void* args[] = {&ka};
    hipError_t e = hipLaunchCooperativeKernel((const void*)fwd_kernel<1>, dim3(grid), dim3(512), args, LDS_BYTES, stream);
    if (e != hipSuccess) fprintf(stderr, "cooperative launch failed: %s (grid %d)\n", hipGetErrorString(e), grid);
#elif MK_COOP == 2
    (void)hipMemsetAsync((char*)d_ws + WS_CTL, 0, CTL_ZERO_BYTES, stream);
    ka.nprog = np; for (int i = 0; i < np; ++i) ka.prog[i] = prog[i];
    hipLaunchKernelGGL(fwd_kernel<2>, dim3(grid), dim3(512), LDS_BYTES, stream, ka);
#else
    for (int p = 0; p < np; ++p) { ka.nprog = 1; ka.prog[0] = prog[p]; hipLaunchKernelGGL(fwd_kernel<0>, dim3(grid), dim3(512), LDS_BYTES, stream, ka); }
#endif
}
```

```cpp
#include <hip/hip_runtime.h>
#include <hip/hip_cooperative_groups.h>
#include <cstdio>
#include <cstdint>
namespace cg = cooperative_groups;

#ifndef MK_COOP
#define MK_COOP 2
#endif

namespace pg8 {
#define PG8_LAS __attribute__((address_space(3)))
typedef unsigned short bf16_t;
typedef short bf16x8 __attribute__((ext_vector_type(8)));
typedef float f32x4 __attribute__((ext_vector_type(4)));
typedef unsigned u32x4 __attribute__((ext_vector_type(4)));
constexpr int BM = 256, BK = 64, HALF = 128, HTB = HALF * BK * 2  , STAGE_BYTES = 8 * HTB, NXCD = 8, WGM = 8;

__host__ __device__ __forceinline__ int lds_byte(int r, int c) { const int st = (r >> 4) * 2 + (c >> 5), rr = r & 15, cc = c & 31, ob = rr * 64 + cc * 2; return st * 1024 + (ob ^ (((ob >> 9) & 1) << 5)); }
__host__ __device__ __forceinline__ void stage_rc(int b, int& R, int& C) { const int st = b / 1024, sb = b % 1024, swz = sb ^ (((sb >> 9) & 1) << 5); R = (st >> 1) * 16 + swz / 64; C = (st & 1) * 32 + (swz % 64) / 2; }
__host__ __device__ __forceinline__ int perm32(int rho) { const int n = rho >> 4, i = rho & 15; return 8 * (i >> 2) + 4 * n + (i & 3); }

struct Unit { int pm, pn; };
struct Gemm { const bf16_t* A; const bf16_t* Bt; int M, N, K, lda; unsigned* dummy; };

struct StaticOrder {
    int nM, nN, nwg, G, c;
    __host__ __device__ void init(int M, int N, int G_, int c_) { nM = M / BM; nN = N / BM; nwg = nM * nN; G = G_; c = c_; }
    __host__ __device__ bool next(int i, Unit& u) const {
        const long L = (long)i * G + c; if (L >= nwg) return false;
        int wgid = (int)L; { const int q = nwg / NXCD, r = nwg % NXCD, xcd = wgid % NXCD, off = wgid / NXCD; wgid = (xcd < r ? xcd * (q + 1) : r * (q + 1) + (xcd - r) * q) + off; }
        const int nig = WGM * nN, gid = wgid / nig, fm = gid * WGM, gsz = (nM - fm) < WGM ? (nM - fm) : WGM;
        u.pm = fm + ((wgid % nig) % gsz); u.pn = (wgid % nig) / gsz; return true;
    }
    __device__ __forceinline__ void a_ready(const Unit&) const {}
    __device__ __forceinline__ void done(const Unit&) const {}
};

__device__ __forceinline__ unsigned cvt_pk_bf16(float lo, float hi) { unsigned r; asm volatile("v_cvt_pk_bf16_f32 %0, %1, %2" : "=v"(r) : "v"(lo), "v"(hi)); return r; }

struct EpiBf16 {
    static constexpr bool PERM = true, AFTER_DRAIN = false; static constexpr int NSTORE = 16;
    bf16_t* O; int ldc; float* vstat;
    __device__ __forceinline__ void operator()(const f32x4 (&acc)[2][2][4][2], const Unit& u, int, int, int, int) const {
        int tl = threadIdx.x; asm volatile("" : "+v"(tl));
        const int wid = __builtin_amdgcn_readfirstlane(tl >> 6), wr = wid >> 2, wc = wid & 3, fr = tl & 15, fq = (tl >> 4) & 3;
        const int row0 = u.pm * BM + wr * 64 + fr; const int col0 = u.pn * BM + wc * 32 + 8 * fq;
        const bool st = vstat != nullptr && u.pn >= 4 && u.pn < 8;
#pragma unroll
        for (int ai = 0; ai < 2; ++ai)
#pragma unroll
            for (int m = 0; m < 4; ++m) { const int row = row0 + ai * HALF + m * 16; bf16_t* rowp = O + (size_t)row * ldc + col0; float s = 0.f, q = 0.f;
#pragma unroll
                for (int bj = 0; bj < 2; ++bj) { const f32x4 v0 = acc[ai][bj][m][0], v1 = acc[ai][bj][m][1];
                    u32x4 w; w.x = cvt_pk_bf16(v0[0], v0[1]); w.y = cvt_pk_bf16(v0[2], v0[3]); w.z = cvt_pk_bf16(v1[0], v1[1]); w.w = cvt_pk_bf16(v1[2], v1[3]);
                    *(u32x4*)(rowp + bj * HALF) = w;
                    s += ((v0[0] + v0[1]) + (v0[2] + v0[3])) + ((v1[0] + v1[1]) + (v1[2] + v1[3]));
                    q += (v0[0] * v0[0] + v0[1] * v0[1]) + (v0[2] * v0[2] + v0[3] * v0[3]) + (v1[0] * v1[0] + v1[1] * v1[1]) + (v1[2] * v1[2] + v1[3] * v1[3]); }
                if (st) { s += __shfl_xor(s, 16); s += __shfl_xor(s, 32); q += __shfl_xor(q, 16); q += __shfl_xor(q, 32);
                    if (fq == 0) { typedef float f32x2v __attribute__((ext_vector_type(2))); *(f32x2v*)(vstat + (size_t)row * 32 + 2 * (4 * (u.pn - 4) + wc)) = (f32x2v){s, q}; } } }
    }
};

struct EpiSame {
    static constexpr bool PERM = true, AFTER_DRAIN = false; static constexpr int NSTORE = 0;
    bf16_t* O; int ldc, fpm, fpn;
    __device__ __forceinline__ void operator()(const f32x4 (&acc)[2][2][4][2], const Unit& u, int wr, int wc, int fr, int fq) const {
        const int row0 = fpm * BM + wr * 64 + fr; const int col0 = fpn * BM + wc * 32 + 8 * fq;
#pragma unroll
        for (int ai = 0; ai < 2; ++ai)
#pragma unroll
            for (int m = 0; m < 4; ++m) { bf16_t* rowp = O + (size_t)(row0 + ai * HALF + m * 16) * ldc + col0;
#pragma unroll
                for (int bj = 0; bj < 2; ++bj) { const f32x4 v0 = acc[ai][bj][m][0], v1 = acc[ai][bj][m][1];
                    u32x4 w; w.x = cvt_pk_bf16(v0[0], v0[1]); w.y = cvt_pk_bf16(v0[2], v0[3]); w.z = cvt_pk_bf16(v1[0], v1[1]); w.w = cvt_pk_bf16(v1[2], v1[3]);
                    *(u32x4*)(rowp + bj * HALF) = w; } }
    }
};
struct EpiNone {
    static constexpr bool PERM = true, AFTER_DRAIN = false; static constexpr int NSTORE = 0;
    __device__ __forceinline__ void operator()(const f32x4 (&acc)[2][2][4][2], const Unit& u, int wr, int wc, int fr, int fq) const {
#pragma unroll
        for (int ai = 0; ai < 2; ++ai)
#pragma unroll
            for (int bj = 0; bj < 2; ++bj)
#pragma unroll
                for (int m = 0; m < 4; ++m)
#pragma unroll
                    for (int n = 0; n < 2; ++n) asm volatile("" :: "v"(acc[ai][bj][m][n]));
    }
};

template <int MODE> struct EpiResid {
    static constexpr bool PERM = true, AFTER_DRAIN = false; static constexpr int NSTORE = 0;
    const float* xold; bf16_t* xbf; float* ssq;
    __device__ __forceinline__ void operator()(const f32x4 (&acc)[2][2][4][2], const Unit& u, int, int, int, int) const {
        int tl = threadIdx.x; asm volatile("" : "+v"(tl));
        const int wid = __builtin_amdgcn_readfirstlane(tl >> 6), wr = wid >> 2, wc = wid & 3, fr = tl & 15, fq = (tl >> 4) & 3;
        const int row0 = u.pm * BM + wr * 64 + fr; const int col0 = u.pn * BM + wc * 32 + 8 * fq;
#pragma unroll
        for (int ai = 0; ai < 2; ++ai)
#pragma unroll
            for (int m = 0; m < 4; ++m) { const int row = row0 + ai * HALF + m * 16; const size_t off = (size_t)row * 1024 + col0; float s = 0.f;
#pragma unroll
                for (int bj = 0; bj < 2; ++bj) {
                    f32x4 o0, o1;
                    if (MODE == 0) { o0 = *(const f32x4*)(xold + off + bj * HALF); o1 = *(const f32x4*)(xold + off + bj * HALF + 4); }
                    else { const u32x4 w = *(const u32x4*)(xbf + off + bj * HALF);
                        o0 = (f32x4){__uint_as_float(w.x << 16), __uint_as_float(w.x & 0xffff0000u), __uint_as_float(w.y << 16), __uint_as_float(w.y & 0xffff0000u)};
                        o1 = (f32x4){__uint_as_float(w.z << 16), __uint_as_float(w.z & 0xffff0000u), __uint_as_float(w.w << 16), __uint_as_float(w.w & 0xffff0000u)}; }
                    const f32x4 v0 = o0 + acc[ai][bj][m][0], v1 = o1 + acc[ai][bj][m][1];
                    u32x4 w; w.x = cvt_pk_bf16(v0[0], v0[1]); w.y = cvt_pk_bf16(v0[2], v0[3]); w.z = cvt_pk_bf16(v1[0], v1[1]); w.w = cvt_pk_bf16(v1[2], v1[3]); *(u32x4*)(xbf + off + bj * HALF) = w;
                    s += (v0[0] * v0[0] + v0[1] * v0[1]) + (v0[2] * v0[2] + v0[3] * v0[3]) + (v1[0] * v1[0] + v1[1] * v1[1]) + (v1[2] * v1[2] + v1[3] * v1[3]);
                }
                s += __shfl_xor(s, 16); s += __shfl_xor(s, 32);
                if (fq == 0) ssq[(size_t)row * 16 + u.pn * 4 + wc] = s;
                asm volatile("" ::: "memory"); }
    }
};

template <class Epi, class Sched, bool ALIGN_EPI = false, bool SP2 = false>
__device__ __forceinline__ void gemm_phase(PG8_LAS unsigned char* lds, const Gemm g, const Sched& S, const Epi& E) {
    int tid_ = threadIdx.x; asm volatile("" : "+v"(tid_));
    const int tid = tid_, wid = __builtin_amdgcn_readfirstlane(tid >> 6), lane = tid & 63, wr = wid >> 2, wc = wid & 3, fr = lane & 15, fq = lane >> 4;
    const int K = g.K, nt = K / BK, lda = g.lda;
    unsigned voffA[2], voffB[2];
#pragma unroll
    for (int i = 0; i < 2; ++i) { int R, C; stage_rc(tid * 16 + i * 8192, R, C); const int Rb = Epi::PERM ? ((R & ~31) + perm32(R & 31)) : R;
        voffA[i] = (unsigned)(R * lda + C) * 2u; voffB[i] = (unsigned)(Rb * K + C) * 2u; }
    const size_t kstep = (size_t)(BK * 2);
    const size_t hstepA = (size_t)HALF * lda * 2, hstepB = (size_t)HALF * K * 2;
    const size_t tstepA = 2 * hstepA, tstepB = 2 * hstepB;
    const unsigned ldsw = (unsigned)wid * 1024u;
    const int aoff = lds_byte(wr * 64 + fr, fq * 8), boff = lds_byte(wc * 32 + fr, fq * 8);
#define PG8_SA(b, h) (((b) * 2 + (h)) * HTB)
#define PG8_SB(b, h) ((4 + (b) * 2 + (h)) * HTB)
#define PG8_STAGE(bufoff, gbase, voff) do { _Pragma("unroll") for (int _i = 0; _i < 2; ++_i) \
        __builtin_amdgcn_global_load_lds((const unsigned*)((const char*)(gbase) + (voff)[_i]), (PG8_LAS unsigned*)(lds + (bufoff) + ldsw + _i * 8192), 16, 0, 0); } while (0)
#define PG8_LDA(dst, b, h) do { _Pragma("unroll") for (int m = 0; m < 4; ++m) _Pragma("unroll") for (int k = 0; k < 2; ++k) dst[m][k] = *(const PG8_LAS bf16x8*)(lds + PG8_SA(b, h) + aoff + m * 2048 + k * 1024); } while (0)
#define PG8_LDB(dst, b, h) do { _Pragma("unroll") for (int n = 0; n < 2; ++n) _Pragma("unroll") for (int k = 0; k < 2; ++k) dst[n][k] = *(const PG8_LAS bf16x8*)(lds + PG8_SB(b, h) + boff + n * 2048 + k * 1024); } while (0)
#define PG8_MMA(ai, bj, At, Bt) do { __builtin_amdgcn_s_setprio(1); _Pragma("unroll") for (int m = 0; m < 4; ++m) _Pragma("unroll") for (int n = 0; n < 2; ++n) _Pragma("unroll") for (int k = 0; k < 2; ++k) \
        acc[ai][bj][m][n] = __builtin_amdgcn_mfma_f32_16x16x32_bf16(Bt[n][k], At[m][k], acc[ai][bj][m][n], 0, 0, 0); __builtin_amdgcn_s_setprio(0); } while (0)
#define PG8_WAIT_V(n) asm volatile("s_waitcnt vmcnt(" #n ")" ::: "memory")
#define PG8_WAIT_L(n) asm volatile("s_waitcnt lgkmcnt(" #n ")" ::: "memory")
#define PG8_BAR __builtin_amdgcn_s_barrier()
#define PG8_SCHED __builtin_amdgcn_sched_barrier(0)
    Unit cur, nxt; int ui = 0;
    if (!S.next(0, cur)) return;
    f32x4 acc[2][2][4][2];
#pragma unroll
    for (int a = 0; a < 2; ++a)
#pragma unroll
        for (int b = 0; b < 2; ++b)
#pragma unroll
            for (int m = 0; m < 4; ++m)
#pragma unroll
                for (int n = 0; n < 2; ++n) acc[a][b][m][n] = (f32x4){0.f, 0.f, 0.f, 0.f};
    bf16x8 At[4][2], B0[2][2], B1[2][2];
    const char* cA = (const char*)g.A + (size_t)cur.pm * tstepA; const char* cB = (const char*)g.Bt + (size_t)cur.pn * tstepB;
    S.a_ready(cur);
    if constexpr (SP2) {
        PG8_STAGE(PG8_SB(0, 0), cB, voffB); PG8_STAGE(PG8_SB(0, 1), cB + hstepB, voffB); PG8_STAGE(PG8_SA(0, 0), cA, voffA); PG8_STAGE(PG8_SA(0, 1), cA + hstepA, voffA);
        if (wr == 1) PG8_BAR;
        PG8_WAIT_V(2); PG8_BAR;
        PG8_STAGE(PG8_SB(1, 0), cB + kstep, voffB); PG8_STAGE(PG8_SA(1, 0), cA + kstep, voffA); PG8_STAGE(PG8_SB(1, 1), cB + hstepB + kstep, voffB);
        PG8_WAIT_V(6); PG8_BAR;
        if constexpr (Epi::NSTORE > 0) {
            unsigned* dp = g.dummy + (size_t)blockIdx.x * 512 + tid;
#pragma unroll
            for (int i = 0; i < Epi::NSTORE; ++i) { __builtin_nontemporal_store(0u, dp); asm volatile("" ::: "memory"); }
        }
    } else {
        PG8_STAGE(PG8_SB(0, 0), cB, voffB); PG8_STAGE(PG8_SA(0, 0), cA, voffA); PG8_STAGE(PG8_SB(0, 1), cB + hstepB, voffB); PG8_STAGE(PG8_SA(0, 1), cA + hstepA, voffA);
        if (wr == 1) PG8_BAR;
        PG8_WAIT_V(4); PG8_BAR;
        PG8_STAGE(PG8_SB(1, 0), cB + kstep, voffB); PG8_STAGE(PG8_SA(1, 0), cA + kstep, voffA); PG8_STAGE(PG8_SB(1, 1), cB + hstepB + kstep, voffB);
        PG8_WAIT_V(6); PG8_BAR;
    }
    for (;;) {
        const bool has_next = S.next(ui + 1, nxt);
        const char* nA = has_next ? (const char*)g.A + (size_t)nxt.pm * tstepA : cA; const char* nB = has_next ? (const char*)g.Bt + (size_t)nxt.pn * tstepB : cB;
#define PG8_PTRS(T) const bool last = ((T) == nt - 2); \
            const char* a1 = cA + (size_t)((T) + 1) * kstep; \
            const char* a2 = last ? nA : cA + (size_t)((T) + 2) * kstep; const char* b2 = last ? nB : cB + (size_t)((T) + 2) * kstep; \
            const char* a3 = a2 + kstep; const char* b3 = b2 + kstep; \
            if (last && has_next) S.a_ready(nxt);
        int t = 0;
        if constexpr (SP2 && Epi::NSTORE == 16) {
            PG8_PTRS(0)
            PG8_LDB(B0, 0, 0); PG8_LDB(B1, 0, 1); PG8_SCHED; PG8_LDA(At, 0, 0); PG8_STAGE(PG8_SA(1, 1), a1 + hstepA, voffA);
            PG8_WAIT_V(24);
            PG8_WAIT_L(0); PG8_BAR; PG8_MMA(0, 0, At, B0); PG8_MMA(0, 1, At, B1); PG8_BAR; PG8_SCHED;
            PG8_LDA(At, 0, 1); PG8_STAGE(PG8_SB(0, 0), b2, voffB); PG8_STAGE(PG8_SB(0, 1), b2 + hstepB, voffB); PG8_STAGE(PG8_SA(0, 0), a2, voffA);
            PG8_WAIT_V(24);
            PG8_WAIT_L(0); PG8_BAR; PG8_MMA(1, 0, At, B0); PG8_MMA(1, 1, At, B1); PG8_BAR; PG8_SCHED;
            PG8_LDB(B0, 1, 0); PG8_LDB(B1, 1, 1); PG8_SCHED; PG8_LDA(At, 1, 0); PG8_STAGE(PG8_SA(0, 1), a2 + hstepA, voffA);
            PG8_WAIT_V(8); PG8_WAIT_L(0); PG8_BAR; PG8_MMA(0, 0, At, B0); PG8_MMA(0, 1, At, B1); PG8_BAR; PG8_SCHED;
            PG8_LDA(At, 1, 1); PG8_STAGE(PG8_SB(1, 0), b3, voffB); PG8_STAGE(PG8_SB(1, 1), b3 + hstepB, voffB); PG8_STAGE(PG8_SA(1, 0), a3, voffA);
            PG8_WAIT_V(8); PG8_WAIT_L(0); PG8_BAR; PG8_MMA(1, 0, At, B0); PG8_MMA(1, 1, At, B1); PG8_BAR; PG8_SCHED;
            t = 2;
        }
        for (; t < nt; t += 2) {
            PG8_PTRS(t)
            if constexpr (SP2) {
            PG8_LDB(B0, 0, 0); PG8_LDB(B1, 0, 1); PG8_SCHED; PG8_LDA(At, 0, 0); PG8_STAGE(PG8_SA(1, 1), a1 + hstepA, voffA);
            PG8_WAIT_V(8);
            PG8_WAIT_L(0); PG8_BAR; PG8_MMA(0, 0, At, B0); PG8_MMA(0, 1, At, B1); PG8_BAR; PG8_SCHED;
            PG8_LDA(At, 0, 1); PG8_STAGE(PG8_SB(0, 0), b2, voffB); PG8_STAGE(PG8_SB(0, 1), b2 + hstepB, voffB); PG8_STAGE(PG8_SA(0, 0), a2, voffA);
            PG8_WAIT_V(8);
            PG8_WAIT_L(0); PG8_BAR; PG8_MMA(1, 0, At, B0); PG8_MMA(1, 1, At, B1); PG8_BAR; PG8_SCHED;
            PG8_LDB(B0, 1, 0); PG8_LDB(B1, 1, 1); PG8_SCHED; PG8_LDA(At, 1, 0); PG8_STAGE(PG8_SA(0, 1), a2 + hstepA, voffA);
            PG8_WAIT_V(8); PG8_WAIT_L(0); PG8_BAR; PG8_MMA(0, 0, At, B0); PG8_MMA(0, 1, At, B1); PG8_BAR; PG8_SCHED;
            PG8_LDA(At, 1, 1); PG8_STAGE(PG8_SB(1, 0), b3, voffB); PG8_STAGE(PG8_SB(1, 1), b3 + hstepB, voffB); PG8_STAGE(PG8_SA(1, 0), a3, voffA);
            PG8_WAIT_V(8); PG8_WAIT_L(0); PG8_BAR; PG8_MMA(1, 0, At, B0); PG8_MMA(1, 1, At, B1); PG8_BAR; PG8_SCHED;
            } else {
            PG8_LDB(B0, 0, 0); PG8_SCHED; PG8_LDA(At, 0, 0); PG8_STAGE(PG8_SA(1, 1), a1 + hstepA, voffA);
            PG8_WAIT_L(8); PG8_BAR; PG8_WAIT_L(0); PG8_MMA(0, 0, At, B0); PG8_BAR; PG8_SCHED;
            PG8_LDB(B1, 0, 1); PG8_STAGE(PG8_SB(0, 0), b2, voffB);
            PG8_BAR; PG8_WAIT_L(0); PG8_MMA(0, 1, At, B1); PG8_BAR;
            PG8_LDA(At, 0, 1); PG8_STAGE(PG8_SA(0, 0), a2, voffA);
            PG8_BAR; PG8_WAIT_L(0); PG8_MMA(1, 0, At, B0); PG8_BAR; PG8_SCHED;
            PG8_STAGE(PG8_SB(0, 1), b2 + hstepB, voffB);
            PG8_WAIT_V(6); PG8_BAR; PG8_MMA(1, 1, At, B1); PG8_BAR;
            PG8_LDB(B0, 1, 0); PG8_SCHED; PG8_LDA(At, 1, 0); PG8_STAGE(PG8_SA(0, 1), a2 + hstepA, voffA);
            PG8_WAIT_L(8); PG8_BAR; PG8_WAIT_L(0); PG8_MMA(0, 0, At, B0); PG8_BAR; PG8_SCHED;
            PG8_LDB(B1, 1, 1); PG8_STAGE(PG8_SB(1, 0), b3, voffB);
            PG8_BAR; PG8_WAIT_L(0); PG8_MMA(0, 1, At, B1); PG8_BAR;
            PG8_LDA(At, 1, 1); PG8_STAGE(PG8_SA(1, 0), a3, voffA);
            PG8_BAR; PG8_WAIT_L(0); PG8_MMA(1, 0, At, B0); PG8_BAR; PG8_SCHED;
            PG8_STAGE(PG8_SB(1, 1), b3 + hstepB, voffB);
            PG8_WAIT_V(6); PG8_BAR; PG8_MMA(1, 1, At, B1); PG8_BAR;
            }
        }
#undef PG8_PTRS
        if constexpr (ALIGN_EPI) { if (wr == 0) PG8_BAR; }
        if constexpr (!Epi::AFTER_DRAIN) { E(acc, cur, wr, wc, fr, fq); S.done(cur); }
        if (!has_next) break;
#pragma unroll
        for (int a = 0; a < 2; ++a)
#pragma unroll
            for (int b = 0; b < 2; ++b)
#pragma unroll
                for (int m = 0; m < 4; ++m)
#pragma unroll
                    for (int n = 0; n < 2; ++n) acc[a][b][m][n] = (f32x4){0.f, 0.f, 0.f, 0.f};
        cur = nxt; cA = nA; cB = nB; ++ui;
        if constexpr (ALIGN_EPI) { if (wr == 1) PG8_BAR; }
    }
    PG8_WAIT_V(0);
    if constexpr (!ALIGN_EPI) { if (wr == 0) PG8_BAR; }
    PG8_BAR;
#undef PG8_SA
#undef PG8_SB
#undef PG8_STAGE
#undef PG8_LDA
#undef PG8_LDB
#undef PG8_MMA
#undef PG8_WAIT_V
#undef PG8_WAIT_L
#undef PG8_BAR
#undef PG8_SCHED
}
}

#ifndef PG8_SP2
#define PG8_SP2 true
#endif
#ifndef PG8_ALIGN
#define PG8_ALIGN true
#endif

constexpr int DM = 1024, NPROJ = 5120, DMIX = 2048, DEPTH = 2;
#ifndef LDP_PAD
#define LDP_PAD 0
#endif
constexpr int LDP = NPROJ + LDP_PAD;
constexpr int MP = 32768, MS = 256, MT = MP + MS;
constexpr int NPT = 256, NST = 8, NTILES = NPT + NST;
constexpr int PST = 15, DSEQ = 32, PAST = 4096;
constexpr float EPS = 1e-6f;
constexpr size_t OUT_Y = 0, OUT_SPP = (size_t)MT * DM, OUT_SPS = OUT_SPP + (size_t)DEPTH * 8 * PST * DM, OUT_CV = OUT_SPS + (size_t)DEPTH * 8 * PST * DM, OUT_END = OUT_CV + (size_t)DEPTH * 8 * DSEQ * DM;
constexpr size_t MiB = 1u << 20;
constexpr size_t WS_DUMMY = 1 * MiB;
constexpr size_t WS_W1T = 2 * MiB;
constexpr size_t WS_W2T = 22 * MiB;
constexpr size_t WS_WPT = 30 * MiB;
constexpr size_t WS_WSP = 31 * MiB;
constexpr size_t WS_SSQ = 32 * MiB;
constexpr size_t WS_HS = 35 * MiB;
constexpr size_t WS_XBF = 36 * MiB;
constexpr size_t WS_PROJ = 104 * MiB;
constexpr size_t WS_VST = 440 * MiB;
constexpr size_t WS_END = WS_VST + (size_t)MP * 32 * 4;
static_assert(WS_PROJ + (size_t)MT * LDP * 2 <= WS_VST, "d_ws map");
static_assert(WS_SSQ + (size_t)MT * 16 * 4 <= WS_XBF && WS_XBF + (size_t)MT * DM * 2 <= WS_PROJ, "d_ws map");

constexpr int SC_OFF = 131072;
constexpr int LDS_BYTES = 147456;

#define LAS __attribute__((address_space(3)))
typedef unsigned short bf16_t;
typedef short bf16x8 __attribute__((ext_vector_type(8)));
typedef short s16x4 __attribute__((ext_vector_type(4)));
typedef float f32x4 __attribute__((ext_vector_type(4)));
typedef float f32x2 __attribute__((ext_vector_type(2)));
typedef __bf16 bf16x2_t __attribute__((ext_vector_type(2)));
typedef unsigned u32x4 __attribute__((ext_vector_type(4)));
typedef unsigned u32x2 __attribute__((ext_vector_type(2)));
#define LDS_WAIT() asm volatile("s_waitcnt lgkmcnt(0)" ::: "memory")

__device__ __forceinline__ unsigned pk2(float lo, float hi) { f32x2 v = {lo, hi}; bf16x2_t b = __builtin_convertvector(v, bf16x2_t); return __builtin_bit_cast(unsigned, b); }
__device__ __forceinline__ float bflo(unsigned w) { return __uint_as_float(w << 16); }
__device__ __forceinline__ float bfhi(unsigned w) { return __uint_as_float(w & 0xffff0000u); }
__device__ __forceinline__ float wave_sum(float v) {
#pragma unroll
    for (int o = 1; o < 64; o <<= 1) v += __shfl_xor(v, o);
    return v;
}
__device__ __forceinline__ float silu_f(float z) { return z * __builtin_amdgcn_rcpf(1.0f + __expf(-z)); }
__device__ __forceinline__ float rsqrt_f(float x) { return __builtin_amdgcn_rsqf(x); }
__device__ __forceinline__ void unpack8(const u32x4 w, float (&f)[8]) { f[0] = bflo(w.x); f[1] = bfhi(w.x); f[2] = bflo(w.y); f[3] = bfhi(w.y); f[4] = bflo(w.z); f[5] = bfhi(w.z); f[6] = bflo(w.w); f[7] = bfhi(w.w); }
__device__ __forceinline__ s16x4 vtr(const LAS unsigned char* p) { typedef short v4i16_t __attribute__((ext_vector_type(4))); return __builtin_bit_cast(s16x4, __builtin_amdgcn_ds_read_tr16_b64_v4i16((LAS v4i16_t*)p)); }
__device__ __forceinline__ unsigned off_b(unsigned row, unsigned ch) { return 256u * row + 16u * (ch ^ (((row & 3) << 2) | ((row >> 2) & 3))); }
__device__ __forceinline__ unsigned tr_addr16(unsigned lane, unsigned c, unsigned ks, unsigned t) {
    const unsigned g = lane >> 4, q = (lane & 15) >> 2, p = lane & 3;
    return off_b(32 * ks + 8 * g + 4 * t + q, 2 * c + (p >> 1)) + 8 * (p & 1);
}

__device__ __forceinline__ void p0_transpose_item(const float* W, int K, int N, bf16_t* WT, const float* kscale, LAS float* scr, int item, int lane) {
    const int nblk = N / 32, kb = item / nblk, nb = item % nblk, k0 = 64 * kb, n0 = 32 * nb;
#pragma unroll 8
    for (int i = 0; i < 32; ++i) { const int kk = 2 * i + (lane >> 5); float v = W[(size_t)(k0 + kk) * N + n0 + (lane & 31)]; if (kscale) v *= kscale[k0 + kk]; scr[kk * 33 + (lane & 31)] = v; }
    LDS_WAIT(); asm volatile("" ::: "memory");
    const int c = lane & 7;
#pragma unroll
    for (int j = 0; j < 4; ++j) { const int n = (lane >> 3) + 8 * j; const LAS float* s = scr + (8 * c) * 33 + n;
        u32x4 o; o.x = pk2(s[0 * 33], s[1 * 33]); o.y = pk2(s[2 * 33], s[3 * 33]); o.z = pk2(s[4 * 33], s[5 * 33]); o.w = pk2(s[6 * 33], s[7 * 33]);
        *(u32x4*)(WT + (size_t)(n0 + n) * K + k0 + 8 * c) = o; }
    LDS_WAIT(); asm volatile("" ::: "memory");
}

struct Args { const float* in[13]; float* out; unsigned char* ws; };

__device__ __forceinline__ void p0_prep(const Args& a, LAS unsigned char* lds, int gw, int NGW, int wave) {
    int tl = threadIdx.x; asm volatile("" : "+v"(tl)); const int lane = tl & 63;
    LAS float* scr = (LAS float*)(lds + wave * 16384);
    unsigned char* ws = a.ws;
    constexpr int I1 = (DM / 64) * (NPROJ / 32), I2 = (DMIX / 64) * (DM / 32), I3 = (256 / 64) * (256 / 32);
    constexpr int NITEMS = DEPTH * I1 + DEPTH * I2 + DEPTH * 4 * I3;
    for (int it = gw; it < NITEMS; it += NGW) {
        int r = it;
        if (r < DEPTH * I1) { const int l = r / I1; r -= l * I1; p0_transpose_item(a.in[4] + (size_t)l * DM * NPROJ, DM, NPROJ, (bf16_t*)(ws + WS_W1T) + (size_t)l * NPROJ * DM, a.in[3] + l * DM, scr, r, lane); continue; }
        r -= DEPTH * I1;
        if (r < DEPTH * I2) { const int l = r / I2; r -= l * I2; p0_transpose_item(a.in[11] + (size_t)l * DMIX * DM, DMIX, DM, (bf16_t*)(ws + WS_W2T) + (size_t)l * DM * DMIX, nullptr, scr, r, lane); continue; }
        r -= DEPTH * I2;
        { const int lg = r / I3; r -= lg * I3; p0_transpose_item(a.in[9] + (size_t)lg * 65536, 256, 256, (bf16_t*)(ws + WS_WPT) + (size_t)lg * 65536, nullptr, scr, r, lane); }
    }
    for (int row = gw; row < DEPTH * 8 * 128; row += NGW) {
        const int i = row & 127; const f32x2 v = *(const f32x2*)(a.in[7] + (size_t)row * 128 + 2 * lane);
        const bool keep = ((2 * lane) >> 6) <= (i >> 6);
        ((unsigned*)(ws + WS_WSP))[(size_t)row * 64 + lane] = keep ? pk2(v.x, v.y) : 0u;
    }
    for (int m = gw; m < DEPTH * 8 * PST; m += NGW) {
        const f32x4* xr = (const f32x4*)(a.in[2] + (size_t)m * DM) + lane; u32x2* o8 = (u32x2*)((bf16_t*)(ws + WS_HS) + (size_t)m * DM) + lane;
#pragma unroll
        for (int j = 0; j < 4; ++j) { const f32x4 v = xr[64 * j]; u32x2 w; w.x = pk2(v.x, v.y); w.y = pk2(v.z, v.w); o8[64 * j] = w; }
    }
    for (int m0 = 4 * gw; m0 < MT; m0 += 4 * NGW) {
        f32x4 v[4][4];
#pragma unroll
        for (int q = 0; q < 4; ++q) { const int m = m0 + q; const float* xrow = (m < MP) ? a.in[0] + (size_t)m * DM : a.in[1] + (size_t)(m - MP) * DM; const f32x4* xr = (const f32x4*)xrow + lane;
#pragma unroll
            for (int j = 0; j < 4; ++j) v[q][j] = xr[64 * j]; }
#pragma unroll
        for (int q = 0; q < 4; ++q) { const int m = m0 + q; float s = 0.f;
#pragma unroll
            for (int j = 0; j < 4; ++j) s += (v[q][j].x * v[q][j].x + v[q][j].y * v[q][j].y) + (v[q][j].z * v[q][j].z + v[q][j].w * v[q][j].w);
            s = wave_sum(s);
            u32x2* o8 = (u32x2*)((bf16_t*)(ws + WS_XBF) + (size_t)m * DM) + lane;
#pragma unroll
            for (int j = 0; j < 4; ++j) { u32x2 w; w.x = pk2(v[q][j].x, v[q][j].y); w.y = pk2(v[q][j].z, v[q][j].w); o8[64 * j] = w; }
            if (lane < 16) ((float*)(ws + WS_SSQ))[(size_t)m * 16 + lane] = (lane == 0) ? s : 0.f; }
    }
}

template <int MTW, int NTW, int KQ, class Epi>
__device__ __forceinline__ void small_gemm(LAS unsigned char* lds, const bf16_t* A, int lda, int kbreak, int kjump, const bf16_t* Bt, int K, int row_base, int col_base, const Epi& E) {
    int tl = threadIdx.x; asm volatile("" : "+v"(tl));
    const int lane = tl & 63, fr = lane & 15, fq = lane >> 4;
    const int wave = __builtin_amdgcn_readfirstlane(tl >> 6), kq = wave % KQ, mh = wave / KQ;
    const int KS = K / KQ, NKS = KS / 32;
    const int r0 = row_base + 16 * MTW * mh, k0 = KS * kq;
    f32x4 acc[MTW][NTW];
#pragma unroll
    for (int mt = 0; mt < MTW; ++mt)
#pragma unroll
        for (int nt = 0; nt < NTW; ++nt) acc[mt][nt] = (f32x4){0.f, 0.f, 0.f, 0.f};
    const bf16_t* ap = A + (size_t)(r0 + fr) * lda + k0 + (k0 >= kbreak ? kjump : 0) + 8 * fq;
    const bf16_t* bp = Bt + (size_t)(col_base + fr) * K + k0 + 8 * fq;
#pragma unroll 1
    for (int kb = 0; kb < NKS; kb += 4) {
        bf16x8 af[MTW][4], bfm[NTW][4];
#pragma unroll
        for (int mt = 0; mt < MTW; ++mt)
#pragma unroll
            for (int j = 0; j < 4; ++j) af[mt][j] = *(const bf16x8*)(ap + (size_t)(16 * mt) * lda + 32 * (kb + j));
#pragma unroll
        for (int nt = 0; nt < NTW; ++nt)
#pragma unroll
            for (int j = 0; j < 4; ++j) bfm[nt][j] = *(const bf16x8*)(bp + (size_t)(16 * nt) * K + 32 * (kb + j));
        __builtin_amdgcn_sched_barrier(0);
#pragma unroll
        for (int j = 0; j < 4; ++j)
#pragma unroll
            for (int mt = 0; mt < MTW; ++mt)
#pragma unroll
                for (int nt = 0; nt < NTW; ++nt) acc[mt][nt] = __builtin_amdgcn_mfma_f32_16x16x32_bf16(bfm[nt][j], af[mt][j], acc[mt][nt], 0, 0, 0);
        __builtin_amdgcn_sched_barrier(0);
    }
    LAS f32x4* part = (LAS f32x4*)lds;
    if (kq > 0) {
#pragma unroll
        for (int mt = 0; mt < MTW; ++mt)
#pragma unroll
            for (int nt = 0; nt < NTW; ++nt) part[(((mh * (KQ - 1) + (kq - 1)) * MTW + mt) * NTW + nt) * 64 + lane] = acc[mt][nt];
    }
    __syncthreads();
    if (kq == 0) {
#pragma unroll
        for (int q = 0; q < KQ - 1; ++q)
#pragma unroll
            for (int mt = 0; mt < MTW; ++mt)
#pragma unroll
                for (int nt = 0; nt < NTW; ++nt) acc[mt][nt] += part[(((mh * (KQ - 1) + q) * MTW + mt) * NTW + nt) * 64 + lane];
        E(acc, r0, col_base, fr, fq);
    }
    __syncthreads();
}
struct SEpiProj {
    bf16_t* O;
    template <int MTW, int NTW> __device__ __forceinline__ void operator()(const f32x4 (&acc)[MTW][NTW], int r0, int c0, int fr, int fq) const {
#pragma unroll
        for (int mt = 0; mt < MTW; ++mt)
#pragma unroll
            for (int nt = 0; nt < NTW; ++nt) { const f32x4 v = acc[mt][nt]; u32x2 w; w.x = pk2(v[0], v[1]); w.y = pk2(v[2], v[3]);
                *(u32x2*)(O + (size_t)(r0 + 16 * mt + fr) * LDP + c0 + 16 * nt + 4 * fq) = w; }
    }
};
template <int MODE> struct SEpiResid {
    const float* xold; bf16_t* xbf; float* ssq;
    template <int MTW, int NTW> __device__ __forceinline__ void operator()(const f32x4 (&acc)[MTW][NTW], int r0, int c0, int fr, int fq) const {
        static_assert(MTW == 1 && NTW == 4, "SEpiResid: 16 x 64 block");
        const int row = r0 + fr; float s = 0.f;
#pragma unroll
        for (int nt = 0; nt < NTW; ++nt) { const size_t off = (size_t)row * DM + c0 + 16 * nt + 4 * fq; f32x4 o;
            if (MODE == 0) o = *(const f32x4*)(xold + off);
            else { const u32x2 w = *(const u32x2*)(xbf + off); o = (f32x4){bflo(w.x), bfhi(w.x), bflo(w.y), bfhi(w.y)}; }
            const f32x4 v = o + acc[0][nt];
            u32x2 w; w.x = pk2(v[0], v[1]); w.y = pk2(v[2], v[3]); *(u32x2*)(xbf + off) = w;
            s += (v[0] * v[0] + v[1] * v[1]) + (v[2] * v[2] + v[3] * v[3]); }
        s += __shfl_xor(s, 16); s += __shfl_xor(s, 32);
        if (fq == 0) ssq[(size_t)row * 16 + (c0 >> 6)] = s;
    }
};

template <int W>
__device__ __forceinline__ void pool_build(LAS unsigned char* dimg, const LAS float* rr, const bf16_t* mb, const bf16_t* hb, int hp, int g, int tid, int ntok, int pos0) {
    constexpr int NR = W + 7;
    const int seg = tid >> 5, chk = tid & 31, t0 = 8 * seg, cb = 256 * g + 8 * chk;
    const LAS float* rq = rr + (t0 - (W - 1) + 15);
    u32x4 raw[NR];
#pragma unroll
    for (int k = 0; k < NR; ++k) {
        const int t = t0 - (W - 1) + k, tc = t < ntok ? t : ntok - 1;
        const bf16_t* p = (t >= 0) ? mb + (size_t)tc * LDP + cb : hb + (size_t)(PST + t) * hp + cb;
        raw[k] = *(const u32x4*)p;
    }
    float s[8];
#pragma unroll
    for (int e = 0; e < 8; ++e) s[e] = 0.f;
#pragma unroll
    for (int k = 0; k < W - 1; ++k) { float f[8]; unpack8(raw[k], f); const float r = rq[k];
#pragma unroll
        for (int e = 0; e < 8; ++e) s[e] += f[e] * r; }
#pragma unroll
    for (int i = 0; i < 8; ++i) {
        const int t = t0 + i; float cur[8]; unpack8(raw[i + W - 1], cur); const float rc = rq[i + W - 1];
#pragma unroll
        for (int e = 0; e < 8; ++e) { cur[e] *= rc; s[e] += cur[e]; }
        const int cnt = (pos0 + t + 1 < W) ? (pos0 + t + 1) : W; const float inv = 1.0f / (float)cnt;
        u32x4 o; o.x = pk2(s[0] * inv - cur[0], s[1] * inv - cur[1]); o.y = pk2(s[2] * inv - cur[2], s[3] * inv - cur[3]);
        o.z = pk2(s[4] * inv - cur[4], s[5] * inv - cur[5]); o.w = pk2(s[6] * inv - cur[6], s[7] * inv - cur[7]);
        *(LAS u32x4*)(dimg + 512 * t + 16 * (chk ^ (t & 15))) = o;
        u32x4 ro = raw[i]; asm volatile("" : "+v"(ro.x), "+v"(ro.y), "+v"(ro.z), "+v"(ro.w));
        float old[8]; unpack8(ro, old); const float r0 = rq[i];
#pragma unroll
        for (int e = 0; e < 8; ++e) s[e] -= old[e] * r0;
    }
}

__device__ __forceinline__ void mixer_tile(const Args& a, LAS unsigned char* lds, int tid_in, int wave, int layer, int tile, int h_lo, int h_hi, int g_lo, int g_hi, int dry = 0) {
    int tid = tid_in; asm volatile("" : "+v"(tid));
    const int lane = tid & 63;
    unsigned char* ws = a.ws;
    bf16_t* proj = (bf16_t*)(ws + WS_PROJ);
    const float* ssq = (const float*)(ws + WS_SSQ);
    const bool samp = tile >= NPT; const int S = tile - NPT;
    const int row0 = samp ? MP + DSEQ * S : tile * 128;
    const int ntok = samp ? DSEQ : 128;
    const int pos0 = samp ? PAST : (tile & 31) * 128;
    const bool has_prev = samp || (tile & 31) != 0;
    const bf16_t* hs = (const bf16_t*)(ws + WS_HS) + ((size_t)layer * 8 + (samp ? S : 0)) * PST * DM;
    const float* ln_g = a.in[5] + layer * DM; const float* ln_b = a.in[6] + layer * DM;
    const bf16_t* wsp = (const bf16_t*)(ws + WS_WSP) + (size_t)layer * 8 * 16384;
    const float* b_sp = a.in[8] + layer * 8 * 128;
    const bf16_t* wpt = (const bf16_t*)(ws + WS_WPT) + (size_t)layer * 4 * 65536;
    const float* pscale = a.in[10] + layer * DM;
    LAS float* rr = (LAS float*)(lds + SC_OFF); LAS float* mu = rr + 144; LAS float* sv = mu + 128;
    const int fr = lane & 15, fq = lane >> 4;

    if (tid < 143) {
        const int t = tid - 15; float r = 0.f;
        const bool from_rows = (t >= 0) ? (t < ntok) : (!samp && has_prev);
        if (from_rows) { const f32x4* p = (const f32x4*)(ssq + (size_t)(row0 + t) * 16); const f32x4 x0 = p[0], x1 = p[1], x2 = p[2], x3 = p[3];
            const float s = ((x0.x + x0.y) + (x0.z + x0.w)) + ((x1.x + x1.y) + (x1.z + x1.w)) + ((x2.x + x2.y) + (x2.z + x2.w)) + ((x3.x + x3.y) + (x3.z + x3.w));
            r = rsqrt_f(s * (1.0f / DM) + EPS); }
        else if (t < 0 && samp) r = 1.f;
        rr[tid] = r;
    }
    __syncthreads();
    if (h_hi > h_lo) {
        if (!samp) {
            if (tid < 128) { const f32x4* p = (const f32x4*)((const float*)(ws + WS_VST) + (size_t)(row0 + tid) * 32); float s = 0.f, q = 0.f;
#pragma unroll
                for (int j = 0; j < 8; ++j) { const f32x4 x = p[j]; s += x.x + x.z; q += x.y + x.w; }
                const float m = s * (1.0f / DM); float var = q * (1.0f / DM) - m * m; var = var > 0.f ? var : 0.f; const float r = rr[tid + 15];
                mu[tid] = m; sv[tid] = r * rsqrt_f(r * r * var + EPS); }
        } else {
#pragma unroll 1
            for (int i0 = 0; i0 < 1; ++i0) {
                const int tb = 4 * wave;
                u32x4 ra[4], rb[4];
#pragma unroll
                for (int i = 0; i < 4; ++i) { const u32x4* p = (const u32x4*)(proj + (size_t)(row0 + tb + i) * LDP + 1024); ra[i] = p[lane]; rb[i] = p[lane + 64]; }
#pragma unroll
                for (int i = 0; i < 4; ++i) { float f[8], s = 0.f, q = 0.f; unpack8(ra[i], f);
#pragma unroll
                    for (int e = 0; e < 8; ++e) { s += f[e]; q += f[e] * f[e]; }
                    unpack8(rb[i], f);
#pragma unroll
                    for (int e = 0; e < 8; ++e) { s += f[e]; q += f[e] * f[e]; }
                    s = wave_sum(s); q = wave_sum(q);
                    const float m = s * (1.0f / DM); float var = q * (1.0f / DM) - m * m; var = var > 0.f ? var : 0.f; const float r = rr[tb + i + 15];
                    if (lane == 0) { mu[tb + i] = m; sv[tb + i] = r * rsqrt_f(r * r * var + EPS); } }
            }
        }
        __syncthreads();
    }
    if (h_hi > h_lo) {
        const int ch8 = tid & 15, tk0 = tid >> 4;
        const int Gw = ch8 >> 2, q8 = ch8 & 3;
        const int wi = wave & 3, wc2 = wave >> 2, it0 = wi, it1 = 7 - wi;
        u32x4 raw[4], uu[2][2], zz[2][2];
#pragma unroll
        for (int i = 0; i < 4; ++i) { const int tok = tk0 + 32 * i, tc = tok < ntok ? tok : ntok - 1; raw[i] = *(const u32x4*)(proj + (size_t)(row0 + tc) * LDP + 1024 + 128 * h_lo + 8 * ch8); }
#pragma unroll
        for (int sel = 0; sel < 2; ++sel) { const int i = 16 * (sel ? it1 : it0) + fr;
#pragma unroll
            for (int G2 = 0; G2 < 2; ++G2) { const bf16_t* pu = proj + (size_t)(row0 + (i < ntok ? i : ntok - 1)) * LDP + 128 * h_lo + 32 * (2 * wc2 + G2) + 8 * fq; uu[sel][G2] = *(const u32x4*)pu; zz[sel][G2] = *(const u32x4*)(pu + 2048); } }
#pragma unroll 1
        for (int h = h_lo; h < h_hi; ++h) {
            LAS unsigned char* img = lds + (h & 1) * 32768;
            { const f32x4 g0 = *(const f32x4*)(ln_g + 128 * h + 8 * ch8), g1 = *(const f32x4*)(ln_g + 128 * h + 8 * ch8 + 4);
              const f32x4 b0 = *(const f32x4*)(ln_b + 128 * h + 8 * ch8), b1 = *(const f32x4*)(ln_b + 128 * h + 8 * ch8 + 4);
#pragma unroll
              for (int i = 0; i < 4; ++i) { const int tok = tk0 + 32 * i; float f[8]; unpack8(raw[i], f);
                  float m = 0.f, sc = 0.f; if (tok < ntok) { m = mu[tok]; sc = sv[tok]; }
                  f32x4 y0, y1;
                  y0.x = (f[0] - m) * sc * g0.x + b0.x; y0.y = (f[1] - m) * sc * g0.y + b0.y; y0.z = (f[2] - m) * sc * g0.z + b0.z; y0.w = (f[3] - m) * sc * g0.w + b0.w;
                  y1.x = (f[4] - m) * sc * g1.x + b1.x; y1.y = (f[5] - m) * sc * g1.y + b1.y; y1.z = (f[6] - m) * sc * g1.z + b1.z; y1.w = (f[7] - m) * sc * g1.w + b1.w;
                  if (tok >= ntok) { y0 = (f32x4){0.f, 0.f, 0.f, 0.f}; y1 = y0; }
                  u32x2 p0, p1; p0.x = pk2(y0.x, y0.y); p0.y = pk2(y0.z, y0.w); p1.x = pk2(y1.x, y1.y); p1.y = pk2(y1.z, y1.w);
                  *(LAS u32x2*)(img + off_b(tok, 4 * Gw + (q8 >> 1)) + 8 * (q8 & 1)) = p0;
                  *(LAS u32x2*)(img + off_b(tok, 4 * Gw + 2 + (q8 >> 1)) + 8 * (q8 & 1)) = p1;
                  if (samp && tok < ntok) { float* cv = a.out + OUT_CV + (((size_t)layer * 8 + S) * DSEQ + tok) * DM + 128 * h + 8 * ch8; *(f32x4*)cv = y0; *(f32x4*)(cv + 4) = y1; }
              } }
            u32x4 un[2][2], zn[2][2];
            { const int hn = (h + 1 < h_hi) ? h + 1 : h;
#pragma unroll
                for (int i = 0; i < 4; ++i) { const int tok = tk0 + 32 * i, tc = tok < ntok ? tok : ntok - 1; raw[i] = *(const u32x4*)(proj + (size_t)(row0 + tc) * LDP + 1024 + 128 * hn + 8 * ch8); }
#pragma unroll
                for (int sel = 0; sel < 2; ++sel) { const int i = 16 * (sel ? it1 : it0) + fr;
#pragma unroll
                    for (int G2 = 0; G2 < 2; ++G2) { const bf16_t* pu = proj + (size_t)(row0 + (i < ntok ? i : ntok - 1)) * LDP + 128 * hn + 32 * (2 * wc2 + G2) + 8 * fq; un[sel][G2] = *(const u32x4*)pu; zn[sel][G2] = *(const u32x4*)(pu + 2048); } }
            }
            const bf16_t* wh = wsp + h * 16384;
            bf16x8 w0[2], w1[4];
#pragma unroll
            for (int ks = 0; ks < 2; ++ks) w0[ks] = *(const bf16x8*)(wh + (16 * it0 + fr) * 128 + 32 * ks + 8 * fq);
#pragma unroll
            for (int ks = 0; ks < 4; ++ks) w1[ks] = *(const bf16x8*)(wh + (16 * it1 + fr) * 128 + 32 * ks + 8 * fq);
            __syncthreads();
            f32x4 acc[2][2][2];
#pragma unroll
            for (int G2 = 0; G2 < 2; ++G2)
#pragma unroll
                for (int n = 0; n < 2; ++n) { const int c = 2 * (2 * wc2 + G2) + n; f32x4 a0 = (f32x4){0.f, 0.f, 0.f, 0.f}, a1 = a0;
#pragma unroll
                    for (int ks = 0; ks < 4; ++ks) {
                        const s16x4 lo = vtr(img + tr_addr16(lane, c, ks, 0)), hi = vtr(img + tr_addr16(lane, c, ks, 1));
                        const bf16x8 af = (bf16x8){lo[0], lo[1], lo[2], lo[3], hi[0], hi[1], hi[2], hi[3]};
                        if (ks < 2) a0 = __builtin_amdgcn_mfma_f32_16x16x32_bf16(af, w0[ks], a0, 0, 0, 0);
                        a1 = __builtin_amdgcn_mfma_f32_16x16x32_bf16(af, w1[ks], a1, 0, 0, 0);
                    }
                    acc[G2][n][0] = a0; acc[G2][n][1] = a1; }
#pragma unroll
            for (int sel = 0; sel < 2; ++sel) { const int i = 16 * (sel ? it1 : it0) + fr;
                if (i < ntok) { const float r = rr[i + 15], bs = b_sp[h * 128 + i];
#pragma unroll
                    for (int G2 = 0; G2 < 2; ++G2) { float fu[8], fz[8], o[8]; unpack8(uu[sel][G2], fu); unpack8(zz[sel][G2], fz);
#pragma unroll
                        for (int e = 0; e < 8; ++e) { const float gate = acc[G2][e >> 2][sel][e & 3] + bs; o[e] = (r * fu[e]) * gate * silu_f(r * fz[e]); }
                        u32x4 w; w.x = pk2(o[0], o[1]); w.y = pk2(o[2], o[3]); w.z = pk2(o[4], o[5]); w.w = pk2(o[6], o[7]);
                        if (!dry) *(u32x4*)(proj + (size_t)(row0 + i) * LDP + 128 * h + 32 * (2 * wc2 + G2) + 8 * fq) = w; else asm volatile("" :: "v"(w)); } } }
#pragma unroll
            for (int sel = 0; sel < 2; ++sel)
#pragma unroll
                for (int G2 = 0; G2 < 2; ++G2) { uu[sel][G2] = un[sel][G2]; zz[sel][G2] = zn[sel][G2]; }
        }
    }
    __syncthreads();
    if (g_lo == 0 && g_hi > 0 && (samp || (tile & 31) == 31)) {
        const int tfirst = ntok - PST;
        float* so = samp ? a.out + OUT_SPS + ((size_t)layer * 8 + S) * PST * DM : a.out + OUT_SPP + ((size_t)layer * 8 + (tile >> 5)) * PST * DM;
        for (int q = tid; q < PST * 128; q += 512) { const int s = q >> 7, ch = q & 127, t = tfirst + s; const float r = rr[t + 15];
            const u32x4 w = *(const u32x4*)(proj + (size_t)(row0 + t) * LDP + 3072 + 8 * ch); float f[8]; unpack8(w, f);
            *(f32x4*)(so + (size_t)s * DM + 8 * ch) = (f32x4){f[0] * r, f[1] * r, f[2] * r, f[3] * r}; *(f32x4*)(so + (size_t)s * DM + 8 * ch + 4) = (f32x4){f[4] * r, f[5] * r, f[6] * r, f[7] * r}; }
    }
    {
#pragma unroll 1
        for (int g = g_lo; g < g_hi; ++g) {
            LAS unsigned char* dimg = lds + (g & 1) * 65536;
            int tl = tid; asm volatile("" : "+v"(tl));
            const int lfr = tl & 15, lfq = (tl >> 4) & 3;
            const bf16_t* wg = wpt + (size_t)g * 65536;
            bf16x8 afr[2][8];
#pragma unroll
            for (int n = 0; n < 2; ++n) { const int dout = 32 * wave + 8 * (lfr >> 2) + 4 * n + (lfr & 3);
#pragma unroll
                for (int ks = 0; ks < 8; ++ks) afr[n][ks] = *(const bf16x8*)(wg + dout * 256 + 32 * ks + 8 * lfq); }
            const bf16_t* mb = proj + (size_t)row0 * LDP + 3072;
            const bf16_t* hb = samp ? hs : (has_prev ? mb - (size_t)PST * LDP : mb); const int hp = samp ? DM : (has_prev ? LDP : 0);
            if (dry == 3) { }
            else if (g == 0) pool_build<2>(dimg, rr, mb, hb, hp, g, tl, ntok, pos0);
            else if (g == 1) pool_build<4>(dimg, rr, mb, hb, hp, g, tl, ntok, pos0);
            else if (g == 2) pool_build<8>(dimg, rr, mb, hb, hp, g, tl, ntok, pos0);
            else pool_build<16>(dimg, rr, mb, hb, hp, g, tl, ntok, pos0);
            __syncthreads();
            if (dry != 2) {
            const int d8 = 256 * g + 32 * wave + 8 * lfq;
            u32x4 zw[8];
#pragma unroll
            for (int tt = 0; tt < 8; ++tt) { const int i = 16 * tt + lfr; zw[tt] = *(const u32x4*)(proj + (size_t)(row0 + (i < ntok ? i : ntok - 1)) * LDP + 4096 + d8); }
            f32x4 acc[2][8];
#pragma unroll
            for (int n = 0; n < 2; ++n)
#pragma unroll
                for (int tt = 0; tt < 8; ++tt) acc[n][tt] = (f32x4){0.f, 0.f, 0.f, 0.f};
#pragma unroll
            for (int ks = 0; ks < 8; ++ks) {
#pragma unroll
                for (int tt = 0; tt < 8; ++tt) { const bf16x8 bfr = *(const LAS bf16x8*)(dimg + 512 * (16 * tt + lfr) + 16 * ((4 * ks + lfq) ^ lfr));
                    acc[0][tt] = __builtin_amdgcn_mfma_f32_16x16x32_bf16(afr[0][ks], bfr, acc[0][tt], 0, 0, 0);
                    acc[1][tt] = __builtin_amdgcn_mfma_f32_16x16x32_bf16(afr[1][ks], bfr, acc[1][tt], 0, 0, 0); }
            }
            const f32x4 s0 = *(const f32x4*)(pscale + d8), s1 = *(const f32x4*)(pscale + d8 + 4);
            const float sc[8] = {s0.x, s0.y, s0.z, s0.w, s1.x, s1.y, s1.z, s1.w};
#pragma unroll
            for (int tt = 0; tt < 8; ++tt) { const int i = 16 * tt + lfr;
                if (i < ntok) { const float r = rr[i + 15]; float fz[8], o[8]; unpack8(zw[tt], fz);
#pragma unroll
                    for (int e = 0; e < 8; ++e) o[e] = acc[e >> 2][tt][e & 3] * sc[e] * silu_f(r * fz[e]);
                    u32x4 w; w.x = pk2(o[0], o[1]); w.y = pk2(o[2], o[3]); w.z = pk2(o[4], o[5]); w.w = pk2(o[6], o[7]);
                    if (!dry) *(u32x4*)(proj + (size_t)(row0 + i) * LDP + (samp ? 4096 : 1024) + d8) = w; else asm volatile("" :: "v"(w)); } }
            } else { asm volatile("" :: "v"(afr[0][0]), "v"(afr[1][7])); }
        }
    }
    __syncthreads();
}

__device__ __forceinline__ void final_norm(const Args& a, int gw, int NGW) {
    int tl = threadIdx.x; asm volatile("" : "+v"(tl)); const int lane = tl & 63;
    const float* ssq = (const float*)(a.ws + WS_SSQ); const float* fg = a.in[12]; const bf16_t* xb = (const bf16_t*)(a.ws + WS_XBF);
    f32x4 gv[2][2];
#pragma unroll
    for (int j = 0; j < 2; ++j) { gv[j][0] = *(const f32x4*)(fg + 8 * (lane + 64 * j)); gv[j][1] = *(const f32x4*)(fg + 8 * (lane + 64 * j) + 4); }
#pragma unroll 2
    for (int m = gw; m < MT; m += NGW) {
        float s = (lane < 16) ? ssq[(size_t)m * 16 + lane] : 0.f; s = wave_sum(s);
        const float r = rsqrt_f(s * (1.0f / DM) + EPS);
        const u32x4* xr = (const u32x4*)(xb + (size_t)m * DM); float* yr = a.out + OUT_Y + (size_t)m * DM;
#pragma unroll
        for (int j = 0; j < 2; ++j) { const u32x4 w = xr[lane + 64 * j]; float f[8]; unpack8(w, f);
            *(f32x4*)(yr + 8 * (lane + 64 * j)) = (f32x4){f[0], f[1], f[2], f[3]} * r * gv[j][0];
            *(f32x4*)(yr + 8 * (lane + 64 * j) + 4) = (f32x4){f[4], f[5], f[6], f[7]} * r * gv[j][1]; }
    }
}

constexpr size_t WS_CTL = 0, CTL_ZERO_BYTES = 65536;
constexpr int BAR_ST_OFF = SC_OFF + 4096;
#define XB_TMO      128
#define XB_XCNT(j)  (256  + 64 * (j))
#define XB_XSUB(j)  (1280 + 64 * (j))
#define XB_XGEN(j)  (2304 + 64 * (j))
#define XB_TOP      3328
#define XB_TOPGEN   3392
#define XCD_BAR_WORDS 3456
#define XB_SPIN_CAP (1u << 18)

__device__ __forceinline__ unsigned xb_ld(unsigned* p)              { return __hip_atomic_load(p, __ATOMIC_RELAXED, __HIP_MEMORY_SCOPE_AGENT); }
__device__ __forceinline__ unsigned xb_add(unsigned* p, unsigned v) { return __hip_atomic_fetch_add(p, v, __ATOMIC_RELAXED, __HIP_MEMORY_SCOPE_AGENT); }
__device__ __forceinline__ unsigned xb_xcc_id() { return (unsigned)__builtin_amdgcn_s_getreg((3 << 11) | 20) & 0xFu; }
#define XB_SPIN(cond, bar) do { unsigned _sp = 0; while (cond) { __builtin_amdgcn_s_sleep(1); \
    if ((++_sp & 255u) == 0u) { if (xb_ld(&(bar)[XB_TMO])) break; if (_sp > XB_SPIN_CAP) { atomicAdd(&(bar)[XB_TMO], 1u); break; } } } } while (0)

struct XcdBarrier {
    unsigned* bar; unsigned x;
    volatile LAS unsigned* st;
};

__device__ __forceinline__ XcdBarrier xcd_barrier_post(unsigned* bar, volatile LAS unsigned* st) {
    XcdBarrier b; b.bar = bar; b.x = xb_xcc_id(); b.st = st;
    if (threadIdx.x == 0) (void)xb_add(&bar[XB_XCNT(b.x)], 1u);
    return b;
}
__device__ __forceinline__ void xcd_barrier_complete(unsigned* bar, unsigned x, unsigned& nloc, unsigned& nx) {
    const unsigned G = gridDim.x * gridDim.y * gridDim.z;
    unsigned sum, cnt, mine, sp = 0u;
    for (;;) {
        sum = 0u; cnt = 0u; mine = 0u;
#pragma unroll
        for (unsigned j = 0; j < 16; ++j) { const unsigned c = xb_ld(&bar[XB_XCNT(j)]); sum += c; cnt += (c > 0u) ? 1u : 0u; mine = (j == x) ? c : mine; }
        if (sum == G) break;
        __builtin_amdgcn_s_sleep(1);
        if ((++sp & 255u) == 0u) { if (xb_ld(&bar[XB_TMO])) break; if (sp > XB_SPIN_CAP) { atomicAdd(&bar[XB_TMO], 1u); break; } }
    }
    nloc = mine > 0u ? mine : 1u; nx = cnt > 0u ? cnt : 1u;
}

__device__ __forceinline__ void xcd_barrier(const XcdBarrier& b) {
    asm volatile("s_waitcnt vmcnt(0)" ::: "memory");
    __syncthreads();
    if (threadIdx.x == 0) {
        unsigned* bar = b.bar;
        __builtin_amdgcn_s_waitcnt(0);
        unsigned nloc = b.st[0], nx = b.st[1];
        if (nloc == 0u) { xcd_barrier_complete(bar, b.x, nloc, nx); b.st[0] = nloc; b.st[1] = nx; }
        const unsigned old = xb_add(&bar[XB_XSUB(b.x)], 1u);
        const unsigned gen = old / nloc;
        if (old + 1u == (gen + 1u) * nloc) {
            __builtin_amdgcn_fence(__ATOMIC_RELEASE, "agent");
            asm volatile("s_waitcnt vmcnt(0)" ::: "memory");
            const unsigned og = xb_add(&bar[XB_TOP], 1u);
            const unsigned tg = og / nx;
            if (og + 1u == (tg + 1u) * nx) xb_add(&bar[XB_TOPGEN], 1u);
            else XB_SPIN(xb_ld(&bar[XB_TOPGEN]) == tg, bar);
            __builtin_amdgcn_fence(__ATOMIC_ACQUIRE, "agent");
            xb_add(&bar[XB_XGEN(b.x)], 1u);
            asm volatile("s_waitcnt vmcnt(0)" ::: "memory");
        } else {
            XB_SPIN(xb_ld(&bar[XB_XGEN(b.x)]) == gen, bar);
            __builtin_amdgcn_fence(__ATOMIC_ACQUIRE, "agent");
            asm volatile("s_waitcnt vmcnt(0)" ::: "memory");
        }
    }
    __syncthreads();
}

constexpr int N_PHASES = 8;
#ifndef MK_PROG
#define MK_PROG {0, 1, 2, 3, 4, 5, 6, 7}
#endif
struct KArgs { Args a; int nprog; int prog[15]; };
template <int COOP>
__global__ void __launch_bounds__(512, 2) fwd_kernel(KArgs ka) {
    extern __shared__ __attribute__((aligned(16))) unsigned char lds_raw[];
    LAS unsigned char* lds = (LAS unsigned char*)lds_raw;
    const Args& a = ka.a;
    const int wave = __builtin_amdgcn_readfirstlane(threadIdx.x >> 6);
    const int G = gridDim.x, bx = blockIdx.x;
    const int vcu = (G % 8 == 0) ? (bx % 8) * (G / 8) + bx / 8 : bx;
    const int gw = vcu * 8 + wave, NGW = G * 8;
    unsigned char* ws_in = a.ws;
    XcdBarrier bar; bar.bar = nullptr; bar.x = 0; bar.st = nullptr;
    if (COOP == 2) {
        volatile LAS unsigned* st = (volatile LAS unsigned*)(lds + BAR_ST_OFF);
        if (threadIdx.x < 2) st[threadIdx.x] = 0u;
        __syncthreads();
        bar = xcd_barrier_post((unsigned*)(ws_in + WS_CTL), st);
    }
#pragma unroll 1
    for (int pi = 0; pi < ka.nprog; ++pi) {
        const int ph = ka.prog[pi];
        unsigned char* ws = ws_in; asm volatile("" : "+s"(ws));
        if (ph == 0) { p0_prep(a, lds, gw, NGW, wave); __syncthreads(); }
        else if (ph == 7) final_norm(a, gw, NGW);
        else if (ph == 8) { }
#ifdef MK_PROBES
        else if (ph == 9) {
            pg8::Gemm g{(const bf16_t*)(ws + WS_XBF), (const bf16_t*)(ws + WS_W1T), MP, NPROJ, DM, DM, (unsigned*)(ws + WS_DUMMY)};
            pg8::StaticOrder S; S.init(MP, NPROJ, G, bx); pg8::EpiNone E;
            pg8::gemm_phase<pg8::EpiNone, pg8::StaticOrder, PG8_ALIGN, PG8_SP2>(lds, g, S, E);
        }
        else if (ph == 11) { for (int tile = bx; tile < NPT; tile += G) mixer_tile(a, lds, threadIdx.x, wave, 0, tile, 0, 8, 0, 0, 1); }
        else if (ph == 12) { for (int tile = bx; tile < NPT; tile += G) mixer_tile(a, lds, threadIdx.x, wave, 0, tile, 0, 0, 0, 4, 1); }
        else if (ph == 13) { for (int tile = bx; tile < NPT; tile += G) mixer_tile(a, lds, threadIdx.x, wave, 0, tile, 0, 0, 0, 4, 2); }
        else if (ph == 14) { for (int tile = bx; tile < NPT; tile += G) mixer_tile(a, lds, threadIdx.x, wave, 0, tile, 0, 0, 0, 4, 3); }
        else if (ph == 10) {
            pg8::Gemm g{(const bf16_t*)(ws + WS_XBF), (const bf16_t*)(ws + WS_W1T), MP, NPROJ, DM, DM, (unsigned*)(ws + WS_DUMMY)};
            pg8::StaticOrder S; S.init(MP, NPROJ, G, bx); pg8::EpiSame E{(bf16_t*)(ws + WS_PROJ), LDP, bx & 127, bx >> 7};
            pg8::gemm_phase<pg8::EpiSame, pg8::StaticOrder, PG8_ALIGN, PG8_SP2>(lds, g, S, E);
        }
#endif
        else if (ph >= 15) { }
        else {
            const int layer = (ph - 1) / 3, kind = (ph - 1) % 3;
            if (kind == 0) {
                const bf16_t* w1t = (const bf16_t*)(ws + WS_W1T) + (size_t)layer * NPROJ * DM;
                pg8::Gemm g{(const bf16_t*)(ws + WS_XBF), w1t, MP, NPROJ, DM, DM, (unsigned*)(ws + WS_DUMMY)};
                pg8::StaticOrder S; S.init(MP, NPROJ, G, bx);
                pg8::EpiBf16 E{(bf16_t*)(ws + WS_PROJ), LDP, (float*)(ws + WS_VST)};
                pg8::gemm_phase<pg8::EpiBf16, pg8::StaticOrder, PG8_ALIGN, PG8_SP2>(lds, g, S, E);
                SEpiProj SE{(bf16_t*)(ws + WS_PROJ)};
                for (int it = bx; it < 256; it += G) small_gemm<2, 5, 4>(lds, (const bf16_t*)(ws + WS_XBF), DM, 1 << 30, 0, w1t, DM, MP + 64 * (it & 3), 80 * (it >> 2), SE);
            } else if (kind == 1) {
                for (int tile = bx; tile < NPT; tile += G) mixer_tile(a, lds, threadIdx.x, wave, layer, tile, 0, 8, 0, 4);
                for (int it = bx; it < NST * 12; it += G) { const int S = it / 12, part = it % 12;
                    if (part < 8) mixer_tile(a, lds, threadIdx.x, wave, layer, NPT + S, part, part + 1, 0, 0);
                    else mixer_tile(a, lds, threadIdx.x, wave, layer, NPT + S, 0, 0, part - 8, part - 7); }
            } else {
                const bf16_t* w2t = (const bf16_t*)(ws + WS_W2T) + (size_t)layer * DM * DMIX;
                pg8::Gemm g{(const bf16_t*)(ws + WS_PROJ), w2t, MP, DM, DMIX, LDP, (unsigned*)(ws + WS_DUMMY)};
                pg8::StaticOrder S; S.init(MP, DM, G, bx);
                bf16_t* xbf = (bf16_t*)(ws + WS_XBF); float* ssq = (float*)(ws + WS_SSQ);
                {
                    pg8::EpiResid<1> E{nullptr, xbf, ssq}; SEpiResid<1> SE{nullptr, xbf, ssq};
                    pg8::gemm_phase<pg8::EpiResid<1>, pg8::StaticOrder, PG8_ALIGN, PG8_SP2>(lds, g, S, E);
                    for (int it = bx; it < 256; it += G) small_gemm<1, 4, 8>(lds, (const bf16_t*)(ws + WS_PROJ), LDP, 1024, 3072, w2t, DMIX, MP + 16 * (it & 15), 64 * (it >> 4), SE);
                }
            }
        }
        if (pi + 1 < ka.nprog) { if (COOP == 1) cg::this_grid().sync(); else if (COOP == 2) xcd_barrier(bar); }
    }
}

extern "C" void kernel_launch(void* const* d_in, const int* in_sizes, int n_in, void* d_out, int out_size, void* d_ws, size_t ws_size, hipStream_t stream) {
    static int grid = 0;
    if (grid == 0) {
        if (n_in != 13 || in_sizes[0] != MP * DM || (size_t)out_size != OUT_END || ws_size < WS_END) {
            fprintf(stderr, "kernel_launch: unexpected shapes: n_in %d in0 %d out %d ws %zu (need %zu); nothing launched\n", n_in, n_in > 0 ? in_sizes[0] : -1, out_size, ws_size, (size_t)WS_END); grid = -1; return; }
        int dev = 0, cus = 0, per_cu = 0;
        (void)hipGetDevice(&dev); (void)hipDeviceGetAttribute(&cus, hipDeviceAttributeMultiprocessorCount, dev);
        (void)hipFuncSetAttribute((const void*)fwd_kernel<MK_COOP>, hipFuncAttributeMaxDynamicSharedMemorySize, LDS_BYTES);
        (void)hipOccupancyMaxActiveBlocksPerMultiprocessor(&per_cu, (const void*)fwd_kernel<MK_COOP>, 512, LDS_BYTES);
        (void)hipGetLastError();
        if (per_cu < 1) { fprintf(stderr, "kernel_launch: occupancy query says %d blocks per CU\n", per_cu); per_cu = 1; }
        grid = cus * 1;
    }
    if (grid < 0) return;
    KArgs ka{};
    for (int i = 0; i < 13; ++i) ka.a.in[i] = (const float*)d_in[i];
    ka.a.out = (float*)d_out; ka.a.ws = (unsigned char*)d_ws;
    const int prog[] = MK_PROG; const int np = (int)(sizeof(prog) / sizeof(prog[0]));
#if MK_COOP == 1
    ka.nprog = np; for (int i = 0; i < np; ++i) ka.prog[i] = prog[i];
    void* args[] = {&ka};
    hipError_t e = hipLaunchCooperativeKernel((const void*)fwd_kernel<1>, dim3(grid), dim3(512), args, LDS_BYTES, stream);
    if (e != hipSuccess) fprintf(stderr, "cooperative launch failed: %s (grid %d)\n", hipGetErrorString(e), grid);
#elif MK_COOP == 2
    (void)hipMemsetAsync((char*)d_ws + WS_CTL, 0, CTL_ZERO_BYTES, stream);
    ka.nprog = np; for (int i = 0; i < np; ++i) ka.prog[i] = prog[i];
    hipLaunchKernelGGL(fwd_kernel<2>, dim3(grid), dim3(512), LDS_BYTES, stream, ka);
#else
    for (int p = 0; p < np; ++p) { ka.nprog = 1; ka.prog[0] = prog[p]; hipLaunchKernelGGL(fwd_kernel<0>, dim3(grid), dim3(512), LDS_BYTES, stream, ka); }
#endif
}
```

```cpp
#include <hip/hip_runtime.h>
#include <hip/hip_cooperative_groups.h>
#include <cstdio>
#include <cstdint>
namespace cg = cooperative_groups;

#ifndef MK_COOP
#define MK_COOP 2
#endif

__device__ __forceinline__ float xsum16(float v) { return v + __int_as_float(__builtin_amdgcn_ds_swizzle(__float_as_int(v), 0x401F)); }
__device__ __forceinline__ float xsum32(float v) { const auto r = __builtin_amdgcn_permlane32_swap(__float_as_uint(v), __float_as_uint(v), false, false); return __uint_as_float(r[0]) + __uint_as_float(r[1]); }
__device__ __forceinline__ float wave_sum(float v) {
    v += __int_as_float(__builtin_amdgcn_update_dpp(0, __float_as_int(v), 0xB1, 0xF, 0xF, false));
    v += __int_as_float(__builtin_amdgcn_update_dpp(0, __float_as_int(v), 0x4E, 0xF, 0xF, false));
    v += __int_as_float(__builtin_amdgcn_update_dpp(0, __float_as_int(v), 0x141, 0xF, 0xF, false));
    v += __int_as_float(__builtin_amdgcn_update_dpp(0, __float_as_int(v), 0x140, 0xF, 0xF, false));
    return xsum32(xsum16(v));
}
namespace pg8 {
#define PG8_LAS __attribute__((address_space(3)))
typedef unsigned short bf16_t;
typedef short bf16x8 __attribute__((ext_vector_type(8)));
typedef float f32x4 __attribute__((ext_vector_type(4)));
typedef unsigned u32x4 __attribute__((ext_vector_type(4)));
constexpr int BM = 256, BK = 64, HALF = 128, HTB = HALF * BK * 2  , STAGE_BYTES = 8 * HTB, NXCD = 8, WGM = 8;

__host__ __device__ __forceinline__ int lds_byte(int r, int c) { const int st = (r >> 4) * 2 + (c >> 5), rr = r & 15, cc = c & 31, ob = rr * 64 + cc * 2; return st * 1024 + (ob ^ (((ob >> 9) & 1) << 5)); }
__host__ __device__ __forceinline__ void stage_rc(int b, int& R, int& C) { const int st = b / 1024, sb = b % 1024, swz = sb ^ (((sb >> 9) & 1) << 5); R = (st >> 1) * 16 + swz / 64; C = (st & 1) * 32 + (swz % 64) / 2; }
__host__ __device__ __forceinline__ int perm32(int rho) { const int n = rho >> 4, i = rho & 15; return 8 * (i >> 2) + 4 * n + (i & 3); }

struct Unit { int pm, pn; };
struct Gemm { const bf16_t* A; const bf16_t* Bt; int M, N, K, lda; unsigned* dummy; };

struct StaticOrder {
    int nM, nN, nwg, G, c;
    __host__ __device__ void init(int M, int N, int G_, int c_) { nM = M / BM; nN = N / BM; nwg = nM * nN; G = G_; c = c_; }
    __host__ __device__ bool next(int i, Unit& u) const {
        const long L = (long)i * G + c; if (L >= nwg) return false;
        int wgid = (int)L; { const int q = nwg / NXCD, r = nwg % NXCD, xcd = wgid % NXCD, off = wgid / NXCD; wgid = (xcd < r ? xcd * (q + 1) : r * (q + 1) + (xcd - r) * q) + off; }
        const int nig = WGM * nN, gid = wgid / nig, fm = gid * WGM, gsz = (nM - fm) < WGM ? (nM - fm) : WGM;
        u.pm = fm + ((wgid % nig) % gsz); u.pn = (wgid % nig) / gsz; return true;
    }
    __device__ __forceinline__ void a_ready(const Unit&) const {}
    __device__ __forceinline__ void done(const Unit&) const {}
};

__device__ __forceinline__ unsigned cvt_pk_bf16(float lo, float hi) { unsigned r; asm volatile("v_cvt_pk_bf16_f32 %0, %1, %2" : "=v"(r) : "v"(lo), "v"(hi)); return r; }

struct EpiBf16 {
    static constexpr int PERM = 2; static constexpr bool AFTER_DRAIN = false; static constexpr int NSTORE = 16;
    bf16_t* O; int ldc; float* vstat; PG8_LAS unsigned char* scr;
    __device__ __forceinline__ void operator()(const f32x4 (&acc)[2][2][4][2], const Unit& u, int, int, int, int) const {
        int tl = threadIdx.x; asm volatile("" : "+v"(tl));
        const int wid = __builtin_amdgcn_readfirstlane(tl >> 6), wr = wid >> 2, wc = wid & 3, fr = tl & 15, fq = (tl >> 4) & 3, rrow = (tl >> 3) & 7, rch = tl & 7;
        const int row0 = u.pm * BM + wr * 64;
        const bool st = vstat != nullptr && u.pn >= 4 && u.pn < 8;
        PG8_LAS unsigned char* my = scr + wid * 2304;
        PG8_LAS u32x4* wp = (PG8_LAS u32x4*)(my + fr * 144 + 16 * fq);
        const PG8_LAS u32x4* rp = (const PG8_LAS u32x4*)(my + rrow * 144 + 16 * rch);
        bf16_t* op = O + (size_t)(row0 + rrow) * ldc + u.pn * BM + wc * 64 + 8 * rch;
#pragma unroll
        for (int ai = 0; ai < 2; ++ai)
#pragma unroll
            for (int m = 0; m < 4; ++m) { float s = 0.f, q = 0.f;
#pragma unroll
                for (int bj = 0; bj < 2; ++bj) { const f32x4 v0 = acc[ai][bj][m][0], v1 = acc[ai][bj][m][1];
                    u32x4 w; w.x = cvt_pk_bf16(v0[0], v0[1]); w.y = cvt_pk_bf16(v0[2], v0[3]); w.z = cvt_pk_bf16(v1[0], v1[1]); w.w = cvt_pk_bf16(v1[2], v1[3]);
                    wp[4 * bj] = w;
                    s += ((v0[0] + v0[1]) + (v0[2] + v0[3])) + ((v1[0] + v1[1]) + (v1[2] + v1[3]));
                    q += (v0[0] * v0[0] + v0[1] * v0[1]) + (v0[2] * v0[2] + v0[3] * v0[3]) + (v1[0] * v1[0] + v1[1] * v1[1]) + (v1[2] * v1[2] + v1[3] * v1[3]); }
                const u32x4 o0 = rp[0], o1 = rp[72];
                bf16_t* orow = op + (size_t)(ai * HALF + m * 16) * ldc;
                *(u32x4*)orow = o0; *(u32x4*)(orow + (size_t)8 * ldc) = o1;
                if (st) { s = xsum32(xsum16(s)); q = xsum32(xsum16(q));
                    if (fq == 0) { typedef float f32x2v __attribute__((ext_vector_type(2))); *(f32x2v*)(vstat + (size_t)(row0 + ai * HALF + m * 16 + fr) * 32 + 2 * (4 * (u.pn - 4) + wc)) = (f32x2v){s, q}; } } }
    }
};

struct EpiSame {
    static constexpr int PERM = 1; static constexpr bool AFTER_DRAIN = false; static constexpr int NSTORE = 0;
    bf16_t* O; int ldc, fpm, fpn;
    __device__ __forceinline__ void operator()(const f32x4 (&acc)[2][2][4][2], const Unit& u, int wr, int wc, int fr, int fq) const {
        const int row0 = fpm * BM + wr * 64 + fr; const int col0 = fpn * BM + wc * 32 + 8 * fq;
#pragma unroll
        for (int ai = 0; ai < 2; ++ai)
#pragma unroll
            for (int m = 0; m < 4; ++m) { bf16_t* rowp = O + (size_t)(row0 + ai * HALF + m * 16) * ldc + col0;
#pragma unroll
                for (int bj = 0; bj < 2; ++bj) { const f32x4 v0 = acc[ai][bj][m][0], v1 = acc[ai][bj][m][1];
                    u32x4 w; w.x = cvt_pk_bf16(v0[0], v0[1]); w.y = cvt_pk_bf16(v0[2], v0[3]); w.z = cvt_pk_bf16(v1[0], v1[1]); w.w = cvt_pk_bf16(v1[2], v1[3]);
                    *(u32x4*)(rowp + bj * HALF) = w; } }
    }
};
struct EpiNone {
    static constexpr int PERM = 1; static constexpr bool AFTER_DRAIN = false; static constexpr int NSTORE = 0;
    __device__ __forceinline__ void operator()(const f32x4 (&acc)[2][2][4][2], const Unit& u, int wr, int wc, int fr, int fq) const {
#pragma unroll
        for (int ai = 0; ai < 2; ++ai)
#pragma unroll
            for (int bj = 0; bj < 2; ++bj)
#pragma unroll
                for (int m = 0; m < 4; ++m)
#pragma unroll
                    for (int n = 0; n < 2; ++n) asm volatile("" :: "v"(acc[ai][bj][m][n]));
    }
};

template <int MODE> struct EpiResid {
    static constexpr int PERM = 1; static constexpr bool AFTER_DRAIN = false; static constexpr int NSTORE = 0;
    const float* xold; bf16_t* xbf; float* ssq;
    __device__ __forceinline__ void operator()(const f32x4 (&acc)[2][2][4][2], const Unit& u, int, int, int, int) const {
        int tl = threadIdx.x; asm volatile("" : "+v"(tl));
        const int wid = __builtin_amdgcn_readfirstlane(tl >> 6), wr = wid >> 2, wc = wid & 3, fr = tl & 15, fq = (tl >> 4) & 3;
        const int row0 = u.pm * BM + wr * 64 + fr; const int col0 = u.pn * BM + wc * 32 + 8 * fq;
#pragma unroll
        for (int ai = 0; ai < 2; ++ai)
#pragma unroll
            for (int m = 0; m < 4; ++m) { const int row = row0 + ai * HALF + m * 16; const size_t off = (size_t)row * 1024 + col0; float s = 0.f;
#pragma unroll
                for (int bj = 0; bj < 2; ++bj) {
                    f32x4 o0, o1;
                    if (MODE == 0) { o0 = *(const f32x4*)(xold + off + bj * HALF); o1 = *(const f32x4*)(xold + off + bj * HALF + 4); }
                    else { const u32x4 w = *(const u32x4*)(xbf + off + bj * HALF);
                        o0 = (f32x4){__uint_as_float(w.x << 16), __uint_as_float(w.x & 0xffff0000u), __uint_as_float(w.y << 16), __uint_as_float(w.y & 0xffff0000u)};
                        o1 = (f32x4){__uint_as_float(w.z << 16), __uint_as_float(w.z & 0xffff0000u), __uint_as_float(w.w << 16), __uint_as_float(w.w & 0xffff0000u)}; }
                    const f32x4 v0 = o0 + acc[ai][bj][m][0], v1 = o1 + acc[ai][bj][m][1];
                    u32x4 w; w.x = cvt_pk_bf16(v0[0], v0[1]); w.y = cvt_pk_bf16(v0[2], v0[3]); w.z = cvt_pk_bf16(v1[0], v1[1]); w.w = cvt_pk_bf16(v1[2], v1[3]); *(u32x4*)(xbf + off + bj * HALF) = w;
                    s += (v0[0] * v0[0] + v0[1] * v0[1]) + (v0[2] * v0[2] + v0[3] * v0[3]) + (v1[0] * v1[0] + v1[1] * v1[1]) + (v1[2] * v1[2] + v1[3] * v1[3]);
                }
                s = xsum32(xsum16(s));
                if (fq == 0) ssq[(size_t)row * 16 + u.pn * 4 + wc] = s;
                asm volatile("" ::: "memory"); }
    }
};

template <class Epi, class Sched, bool ALIGN_EPI = false, bool SP2 = false>
__device__ __forceinline__ void gemm_phase(PG8_LAS unsigned char* lds, const Gemm g, const Sched& S, const Epi& E) {
    int tid_ = threadIdx.x; asm volatile("" : "+v"(tid_));
    const int tid = tid_, wid = __builtin_amdgcn_readfirstlane(tid >> 6), lane = tid & 63, wr = wid >> 2, wc = wid & 3, fr = lane & 15, fq = lane >> 4;
    const int K = g.K, nt = K / BK, lda = g.lda;
    unsigned voffA[2], voffB[2];
#pragma unroll
    for (int i = 0; i < 2; ++i) { int R, C; stage_rc(tid * 16 + i * 8192, R, C); const int Rb = (int)Epi::PERM == 2 ? (2 * (R & ~31) + perm32(R & 31)) : (int)Epi::PERM == 1 ? ((R & ~31) + perm32(R & 31)) : R;
        voffA[i] = (unsigned)(R * lda + C) * 2u; voffB[i] = (unsigned)(Rb * K + C) * 2u; }
    const size_t kstep = (size_t)(BK * 2);
    const size_t hstepA = (size_t)HALF * lda * 2, hstepB = (size_t)((int)Epi::PERM == 2 ? 32 : HALF) * K * 2;
    const size_t tstepA = (size_t)BM * lda * 2, tstepB = (size_t)BM * K * 2;
    const unsigned ldsw = (unsigned)wid * 1024u;
    const int aoff = lds_byte(wr * 64 + fr, fq * 8), boff = lds_byte(wc * 32 + fr, fq * 8);
#define PG8_SA(b, h) (((b) * 2 + (h)) * HTB)
#define PG8_SB(b, h) ((4 + (b) * 2 + (h)) * HTB)
#define PG8_STAGE(bufoff, gbase, voff) do { _Pragma("unroll") for (int _i = 0; _i < 2; ++_i) \
        __builtin_amdgcn_global_load_lds((const unsigned*)((const char*)(gbase) + (voff)[_i]), (PG8_LAS unsigned*)(lds + (bufoff) + ldsw + _i * 8192), 16, 0, 0); } while (0)
#define PG8_LDA(dst, b, h) do { _Pragma("unroll") for (int m = 0; m < 4; ++m) _Pragma("unroll") for (int k = 0; k < 2; ++k) dst[m][k] = *(const PG8_LAS bf16x8*)(lds + PG8_SA(b, h) + aoff + m * 2048 + k * 1024); } while (0)
#define PG8_LDB(dst, b, h) do { _Pragma("unroll") for (int n = 0; n < 2; ++n) _Pragma("unroll") for (int k = 0; k < 2; ++k) dst[n][k] = *(const PG8_LAS bf16x8*)(lds + PG8_SB(b, h) + boff + n * 2048 + k * 1024); } while (0)
#define PG8_MMA(ai, bj, At, Bt) do { __builtin_amdgcn_s_setprio(1); _Pragma("unroll") for (int m = 0; m < 4; ++m) _Pragma("unroll") for (int n = 0; n < 2; ++n) _Pragma("unroll") for (int k = 0; k < 2; ++k) \
        acc[ai][bj][m][n] = __builtin_amdgcn_mfma_f32_16x16x32_bf16(Bt[n][k], At[m][k], acc[ai][bj][m][n], 0, 0, 0); __builtin_amdgcn_s_setprio(0); } while (0)
#define PG8_WAIT_V(n) asm volatile("s_waitcnt vmcnt(" #n ")" ::: "memory")
#define PG8_WAIT_L(n) asm volatile("s_waitcnt lgkmcnt(" #n ")" ::: "memory")
#define PG8_BAR __builtin_amdgcn_s_barrier()
#define PG8_SCHED __builtin_amdgcn_sched_barrier(0)
    Unit cur, nxt; int ui = 0;
    if (!S.next(0, cur)) return;
    f32x4 acc[2][2][4][2];
#pragma unroll
    for (int a = 0; a < 2; ++a)
#pragma unroll
        for (int b = 0; b < 2; ++b)
#pragma unroll
            for (int m = 0; m < 4; ++m)
#pragma unroll
                for (int n = 0; n < 2; ++n) acc[a][b][m][n] = (f32x4){0.f, 0.f, 0.f, 0.f};
    bf16x8 At[4][2], B0[2][2], B1[2][2];
    const char* cA = (const char*)g.A + (size_t)cur.pm * tstepA; const char* cB = (const char*)g.Bt + (size_t)cur.pn * tstepB;
    S.a_ready(cur);
    if constexpr (SP2) {
        PG8_STAGE(PG8_SB(0, 0), cB, voffB); PG8_STAGE(PG8_SB(0, 1), cB + hstepB, voffB); PG8_STAGE(PG8_SA(0, 0), cA, voffA); PG8_STAGE(PG8_SA(0, 1), cA + hstepA, voffA);
        if (wr == 1) PG8_BAR;
        PG8_WAIT_V(2); PG8_BAR;
        PG8_STAGE(PG8_SB(1, 0), cB + kstep, voffB); PG8_STAGE(PG8_SA(1, 0), cA + kstep, voffA); PG8_STAGE(PG8_SB(1, 1), cB + hstepB + kstep, voffB);
        PG8_WAIT_V(6); PG8_BAR;
        if constexpr (Epi::NSTORE > 0) {
            unsigned* dp = g.dummy + (size_t)blockIdx.x * 512 + tid;
#pragma unroll
            for (int i = 0; i < Epi::NSTORE; ++i) { __builtin_nontemporal_store(0u, dp); asm volatile("" ::: "memory"); }
        }
    } else {
        PG8_STAGE(PG8_SB(0, 0), cB, voffB); PG8_STAGE(PG8_SA(0, 0), cA, voffA); PG8_STAGE(PG8_SB(0, 1), cB + hstepB, voffB); PG8_STAGE(PG8_SA(0, 1), cA + hstepA, voffA);
        if (wr == 1) PG8_BAR;
        PG8_WAIT_V(4); PG8_BAR;
        PG8_STAGE(PG8_SB(1, 0), cB + kstep, voffB); PG8_STAGE(PG8_SA(1, 0), cA + kstep, voffA); PG8_STAGE(PG8_SB(1, 1), cB + hstepB + kstep, voffB);
        PG8_WAIT_V(6); PG8_BAR;
    }
    for (;;) {
        const bool has_next = S.next(ui + 1, nxt);
        const char* nA = has_next ? (const char*)g.A + (size_t)nxt.pm * tstepA : cA; const char* nB = has_next ? (const char*)g.Bt + (size_t)nxt.pn * tstepB : cB;
#define PG8_PTRS(T) const bool last = ((T) == nt - 2); \
            const char* a1 = cA + (size_t)((T) + 1) * kstep; \
            const char* a2 = last ? nA : cA + (size_t)((T) + 2) * kstep; const char* b2 = last ? nB : cB + (size_t)((T) + 2) * kstep; \
            const char* a3 = a2 + kstep; const char* b3 = b2 + kstep; \
            if (last && has_next) S.a_ready(nxt);
        int t = 0;
        if constexpr (SP2 && Epi::NSTORE == 16) {
            PG8_PTRS(0)
            PG8_LDB(B0, 0, 0); PG8_LDB(B1, 0, 1); PG8_SCHED; PG8_LDA(At, 0, 0); PG8_STAGE(PG8_SA(1, 1), a1 + hstepA, voffA);
            PG8_WAIT_V(24);
            PG8_WAIT_L(0); PG8_BAR; PG8_MMA(0, 0, At, B0); PG8_MMA(0, 1, At, B1); PG8_BAR; PG8_SCHED;
            PG8_LDA(At, 0, 1); PG8_STAGE(PG8_SB(0, 0), b2, voffB); PG8_STAGE(PG8_SB(0, 1), b2 + hstepB, voffB); PG8_STAGE(PG8_SA(0, 0), a2, voffA);
            PG8_WAIT_V(24);
            PG8_WAIT_L(0); PG8_BAR; PG8_MMA(1, 0, At, B0); PG8_MMA(1, 1, At, B1); PG8_BAR; PG8_SCHED;
            PG8_LDB(B0, 1, 0); PG8_LDB(B1, 1, 1); PG8_SCHED; PG8_LDA(At, 1, 0); PG8_STAGE(PG8_SA(0, 1), a2 + hstepA, voffA);
            PG8_WAIT_V(8); PG8_WAIT_L(0); PG8_BAR; PG8_MMA(0, 0, At, B0); PG8_MMA(0, 1, At, B1); PG8_BAR; PG8_SCHED;
            PG8_LDA(At, 1, 1); PG8_STAGE(PG8_SB(1, 0), b3, voffB); PG8_STAGE(PG8_SB(1, 1), b3 + hstepB, voffB); PG8_STAGE(PG8_SA(1, 0), a3, voffA);
            PG8_WAIT_V(8); PG8_WAIT_L(0); PG8_BAR; PG8_MMA(1, 0, At, B0); PG8_MMA(1, 1, At, B1); PG8_BAR; PG8_SCHED;
            t = 2;
        }
        for (; t < nt; t += 2) {
            PG8_PTRS(t)
            if constexpr (SP2) {
            PG8_LDB(B0, 0, 0); PG8_LDB(B1, 0, 1); PG8_SCHED; PG8_LDA(At, 0, 0); PG8_STAGE(PG8_SA(1, 1), a1 + hstepA, voffA);
            PG8_WAIT_V(8);
            PG8_WAIT_L(0); PG8_BAR; PG8_MMA(0, 0, At, B0); PG8_MMA(0, 1, At, B1); PG8_BAR; PG8_SCHED;
            PG8_LDA(At, 0, 1); PG8_STAGE(PG8_SB(0, 0), b2, voffB); PG8_STAGE(PG8_SB(0, 1), b2 + hstepB, voffB); PG8_STAGE(PG8_SA(0, 0), a2, voffA);
            PG8_WAIT_V(8);
            PG8_WAIT_L(0); PG8_BAR; PG8_MMA(1, 0, At, B0); PG8_MMA(1, 1, At, B1); PG8_BAR; PG8_SCHED;
            PG8_LDB(B0, 1, 0); PG8_LDB(B1, 1, 1); PG8_SCHED; PG8_LDA(At, 1, 0); PG8_STAGE(PG8_SA(0, 1), a2 + hstepA, voffA);
            PG8_WAIT_V(8); PG8_WAIT_L(0); PG8_BAR; PG8_MMA(0, 0, At, B0); PG8_MMA(0, 1, At, B1); PG8_BAR; PG8_SCHED;
            PG8_LDA(At, 1, 1); PG8_STAGE(PG8_SB(1, 0), b3, voffB); PG8_STAGE(PG8_SB(1, 1), b3 + hstepB, voffB); PG8_STAGE(PG8_SA(1, 0), a3, voffA);
            PG8_WAIT_V(8); PG8_WAIT_L(0); PG8_BAR; PG8_MMA(1, 0, At, B0); PG8_MMA(1, 1, At, B1); PG8_BAR; PG8_SCHED;
            } else {
            PG8_LDB(B0, 0, 0); PG8_SCHED; PG8_LDA(At, 0, 0); PG8_STAGE(PG8_SA(1, 1), a1 + hstepA, voffA);
            PG8_WAIT_L(8); PG8_BAR; PG8_WAIT_L(0); PG8_MMA(0, 0, At, B0); PG8_BAR; PG8_SCHED;
            PG8_LDB(B1, 0, 1); PG8_STAGE(PG8_SB(0, 0), b2, voffB);
            PG8_BAR; PG8_WAIT_L(0); PG8_MMA(0, 1, At, B1); PG8_BAR;
            PG8_LDA(At, 0, 1); PG8_STAGE(PG8_SA(0, 0), a2, voffA);
            PG8_BAR; PG8_WAIT_L(0); PG8_MMA(1, 0, At, B0); PG8_BAR; PG8_SCHED;
            PG8_STAGE(PG8_SB(0, 1), b2 + hstepB, voffB);
            PG8_WAIT_V(6); PG8_BAR; PG8_MMA(1, 1, At, B1); PG8_BAR;
            PG8_LDB(B0, 1, 0); PG8_SCHED; PG8_LDA(At, 1, 0); PG8_STAGE(PG8_SA(0, 1), a2 + hstepA, voffA);
            PG8_WAIT_L(8); PG8_BAR; PG8_WAIT_L(0); PG8_MMA(0, 0, At, B0); PG8_BAR; PG8_SCHED;
            PG8_LDB(B1, 1, 1); PG8_STAGE(PG8_SB(1, 0), b3, voffB);
            PG8_BAR; PG8_WAIT_L(0); PG8_MMA(0, 1, At, B1); PG8_BAR;
            PG8_LDA(At, 1, 1); PG8_STAGE(PG8_SA(1, 0), a3, voffA);
            PG8_BAR; PG8_WAIT_L(0); PG8_MMA(1, 0, At, B0); PG8_BAR; PG8_SCHED;
            PG8_STAGE(PG8_SB(1, 1), b3 + hstepB, voffB);
            PG8_WAIT_V(6); PG8_BAR; PG8_MMA(1, 1, At, B1); PG8_BAR;
            }
        }
#undef PG8_PTRS
        if constexpr (ALIGN_EPI) { if (wr == 0) PG8_BAR; }
        if constexpr (!Epi::AFTER_DRAIN) { E(acc, cur, wr, wc, fr, fq); S.done(cur); }
        if (!has_next) break;
#pragma unroll
        for (int a = 0; a < 2; ++a)
#pragma unroll
            for (int b = 0; b < 2; ++b)
#pragma unroll
                for (int m = 0; m < 4; ++m)
#pragma unroll
                    for (int n = 0; n < 2; ++n) acc[a][b][m][n] = (f32x4){0.f, 0.f, 0.f, 0.f};
        cur = nxt; cA = nA; cB = nB; ++ui;
        if constexpr (ALIGN_EPI) { if (wr == 1) PG8_BAR; }
    }
    PG8_WAIT_V(0);
    if constexpr (!ALIGN_EPI) { if (wr == 0) PG8_BAR; }
    PG8_BAR;
#undef PG8_SA
#undef PG8_SB
#undef PG8_STAGE
#undef PG8_LDA
#undef PG8_LDB
#undef PG8_MMA
#undef PG8_WAIT_V
#undef PG8_WAIT_L
#undef PG8_BAR
#undef PG8_SCHED
}
}

#ifndef PG8_SP2
#define PG8_SP2 true
#endif
#ifndef PG8_ALIGN
#define PG8_ALIGN true
#endif

constexpr int DM = 1024, NPROJ = 5120, DMIX = 2048, DEPTH = 2;
#ifndef LDP_PAD
#define LDP_PAD 0
#endif
constexpr int LDP = NPROJ + LDP_PAD;
constexpr int MP = 32768, MS = 256, MT = MP + MS;
constexpr int NPT = 256, NST = 8, NTILES = NPT + NST;
constexpr int PST = 15, DSEQ = 32, PAST = 4096;
constexpr float EPS = 1e-6f;
constexpr size_t OUT_Y = 0, OUT_SPP = (size_t)MT * DM, OUT_SPS = OUT_SPP + (size_t)DEPTH * 8 * PST * DM, OUT_CV = OUT_SPS + (size_t)DEPTH * 8 * PST * DM, OUT_END = OUT_CV + (size_t)DEPTH * 8 * DSEQ * DM;
constexpr size_t MiB = 1u << 20;
constexpr size_t WS_DUMMY = 1 * MiB;
constexpr size_t WS_W1T = 2 * MiB;
constexpr size_t WS_W2T = 22 * MiB;
constexpr size_t WS_WPT = 30 * MiB;
constexpr size_t WS_WSP = 31 * MiB;
constexpr size_t WS_SSQ = 32 * MiB;
constexpr size_t WS_HS = 35 * MiB;
constexpr size_t WS_XBF = 36 * MiB;
constexpr size_t WS_PROJ = 104 * MiB;
constexpr size_t WS_VST = 440 * MiB;
constexpr size_t WS_END = WS_VST + (size_t)MP * 32 * 4;
static_assert(WS_PROJ + (size_t)MT * LDP * 2 <= WS_VST, "d_ws map");
static_assert(WS_SSQ + (size_t)MT * 16 * 4 <= WS_XBF && WS_XBF + (size_t)MT * DM * 2 <= WS_PROJ, "d_ws map");

constexpr int SC_OFF = 131072;
constexpr int EPI_OFF = 139264;
constexpr int LDS_BYTES = 163840;

#define LAS __attribute__((address_space(3)))
typedef unsigned short bf16_t;
typedef short bf16x8 __attribute__((ext_vector_type(8)));
typedef short s16x4 __attribute__((ext_vector_type(4)));
typedef float f32x4 __attribute__((ext_vector_type(4)));
typedef float f32x2 __attribute__((ext_vector_type(2)));
typedef __bf16 bf16x2_t __attribute__((ext_vector_type(2)));
typedef unsigned u32x4 __attribute__((ext_vector_type(4)));
typedef unsigned u32x2 __attribute__((ext_vector_type(2)));
#define LDS_WAIT() asm volatile("s_waitcnt lgkmcnt(0)" ::: "memory")

__device__ __forceinline__ unsigned pk2(float lo, float hi) { f32x2 v = {lo, hi}; bf16x2_t b = __builtin_convertvector(v, bf16x2_t); return __builtin_bit_cast(unsigned, b); }
__device__ __forceinline__ float bflo(unsigned w) { return __uint_as_float(w << 16); }
__device__ __forceinline__ float bfhi(unsigned w) { return __uint_as_float(w & 0xffff0000u); }
__device__ __forceinline__ float silu_f(float z) { return z * __builtin_amdgcn_rcpf(1.0f + __expf(-z)); }
__device__ __forceinline__ float rsqrt_f(float x) { return __builtin_amdgcn_rsqf(x); }
__device__ __forceinline__ void unpack8(const u32x4 w, float (&f)[8]) { f[0] = bflo(w.x); f[1] = bfhi(w.x); f[2] = bflo(w.y); f[3] = bfhi(w.y); f[4] = bflo(w.z); f[5] = bfhi(w.z); f[6] = bflo(w.w); f[7] = bfhi(w.w); }
__device__ __forceinline__ s16x4 vtr(const LAS unsigned char* p) { typedef short v4i16_t __attribute__((ext_vector_type(4))); return __builtin_bit_cast(s16x4, __builtin_amdgcn_ds_read_tr16_b64_v4i16((LAS v4i16_t*)p)); }
__device__ __forceinline__ unsigned off_b(unsigned row, unsigned ch) { return 256u * row + 16u * (ch ^ (((row & 3) << 2) | ((row >> 2) & 3))); }
__device__ __forceinline__ unsigned tr_addr16(unsigned lane, unsigned c, unsigned ks, unsigned t) {
    const unsigned g = lane >> 4, q = (lane & 15) >> 2, p = lane & 3;
    return off_b(32 * ks + 8 * g + 4 * t + q, 2 * c + (p >> 1)) + 8 * (p & 1);
}

__device__ __forceinline__ void p0_transpose_item(const float* W, int K, int N, bf16_t* WT, const float* kscale, LAS float* scr, int item, int lane) {
    const int nblk = N / 32, kb = item / nblk, nb = item % nblk, k0 = 64 * kb, n0 = 32 * nb;
#pragma unroll 8
    for (int i = 0; i < 32; ++i) { const int kk = 2 * i + (lane >> 5); float v = W[(size_t)(k0 + kk) * N + n0 + (lane & 31)]; if (kscale) v *= kscale[k0 + kk]; scr[kk * 33 + (lane & 31)] = v; }
    LDS_WAIT(); asm volatile("" ::: "memory");
    const int c = lane & 7;
#pragma unroll
    for (int j = 0; j < 4; ++j) { const int n = (lane >> 3) + 8 * j; const LAS float* s = scr + (8 * c) * 33 + n;
        u32x4 o; o.x = pk2(s[0 * 33], s[1 * 33]); o.y = pk2(s[2 * 33], s[3 * 33]); o.z = pk2(s[4 * 33], s[5 * 33]); o.w = pk2(s[6 * 33], s[7 * 33]);
        *(u32x4*)(WT + (size_t)(n0 + n) * K + k0 + 8 * c) = o; }
    LDS_WAIT(); asm volatile("" ::: "memory");
}

struct Args { const float* in[13]; float* out; unsigned char* ws; };

__device__ __forceinline__ void p0_prep(const Args& a, LAS unsigned char* lds, int gw, int NGW, int wave) {
    int tl = threadIdx.x; asm volatile("" : "+v"(tl)); const int lane = tl & 63;
    LAS float* scr = (LAS float*)(lds + wave * 16384);
    unsigned char* ws = a.ws;
    constexpr int I1 = (DM / 64) * (NPROJ / 32), I2 = (DMIX / 64) * (DM / 32), I3 = (256 / 64) * (256 / 32);
    constexpr int NITEMS = DEPTH * I1 + DEPTH * I2 + DEPTH * 4 * I3;
    for (int it = gw; it < NITEMS; it += NGW) {
        int r = it;
        if (r < DEPTH * I1) { const int l = r / I1; r -= l * I1; p0_transpose_item(a.in[4] + (size_t)l * DM * NPROJ, DM, NPROJ, (bf16_t*)(ws + WS_W1T) + (size_t)l * NPROJ * DM, a.in[3] + l * DM, scr, r, lane); continue; }
        r -= DEPTH * I1;
        if (r < DEPTH * I2) { const int l = r / I2; r -= l * I2; p0_transpose_item(a.in[11] + (size_t)l * DMIX * DM, DMIX, DM, (bf16_t*)(ws + WS_W2T) + (size_t)l * DM * DMIX, nullptr, scr, r, lane); continue; }
        r -= DEPTH * I2;
        { const int lg = r / I3; r -= lg * I3; p0_transpose_item(a.in[9] + (size_t)lg * 65536, 256, 256, (bf16_t*)(ws + WS_WPT) + (size_t)lg * 65536, nullptr, scr, r, lane); }
    }
    for (int row = gw; row < DEPTH * 8 * 128; row += NGW) {
        const int i = row & 127; const f32x2 v = *(const f32x2*)(a.in[7] + (size_t)row * 128 + 2 * lane);
        const bool keep = ((2 * lane) >> 6) <= (i >> 6);
        ((unsigned*)(ws + WS_WSP))[(size_t)row * 64 + lane] = keep ? pk2(v.x, v.y) : 0u;
    }
    for (int m = gw; m < DEPTH * 8 * PST; m += NGW) {
        const f32x4* xr = (const f32x4*)(a.in[2] + (size_t)m * DM) + lane; u32x2* o8 = (u32x2*)((bf16_t*)(ws + WS_HS) + (size_t)m * DM) + lane;
#pragma unroll
        for (int j = 0; j < 4; ++j) { const f32x4 v = xr[64 * j]; u32x2 w; w.x = pk2(v.x, v.y); w.y = pk2(v.z, v.w); o8[64 * j] = w; }
    }
    for (int m0 = 4 * gw; m0 < MT; m0 += 4 * NGW) {
        f32x4 v[4][4];
#pragma unroll
        for (int q = 0; q < 4; ++q) { const int m = m0 + q; const float* xrow = (m < MP) ? a.in[0] + (size_t)m * DM : a.in[1] + (size_t)(m - MP) * DM; const f32x4* xr = (const f32x4*)xrow + lane;
#pragma unroll
            for (int j = 0; j < 4; ++j) v[q][j] = xr[64 * j]; }
#pragma unroll
        for (int q = 0; q < 4; ++q) { const int m = m0 + q; float s = 0.f;
#pragma unroll
            for (int j = 0; j < 4; ++j) s += (v[q][j].x * v[q][j].x + v[q][j].y * v[q][j].y) + (v[q][j].z * v[q][j].z + v[q][j].w * v[q][j].w);
            s = wave_sum(s);
            u32x2* o8 = (u32x2*)((bf16_t*)(ws + WS_XBF) + (size_t)m * DM) + lane;
#pragma unroll
            for (int j = 0; j < 4; ++j) { u32x2 w; w.x = pk2(v[q][j].x, v[q][j].y); w.y = pk2(v[q][j].z, v[q][j].w); o8[64 * j] = w; }
            if (lane < 16) ((float*)(ws + WS_SSQ))[(size_t)m * 16 + lane] = (lane == 0) ? s : 0.f; }
    }
}

template <int MTW, int NTW, int KQ, class Epi>
__device__ __forceinline__ void small_gemm(LAS unsigned char* lds, const bf16_t* A, int lda, int kbreak, int kjump, const bf16_t* Bt, int K, int row_base, int col_base, const Epi& E) {
    int tl = threadIdx.x; asm volatile("" : "+v"(tl));
    const int lane = tl & 63, fr = lane & 15, fq = lane >> 4;
    const int wave = __builtin_amdgcn_readfirstlane(tl >> 6), kq = wave % KQ, mh = wave / KQ;
    const int KS = K / KQ, NKS = KS / 32;
    const int r0 = row_base + 16 * MTW * mh, k0 = KS * kq;
    f32x4 acc[MTW][NTW];
#pragma unroll
    for (int mt = 0; mt < MTW; ++mt)
#pragma unroll
        for (int nt = 0; nt < NTW; ++nt) acc[mt][nt] = (f32x4){0.f, 0.f, 0.f, 0.f};
    const bf16_t* ap = A + (size_t)(r0 + fr) * lda + k0 + (k0 >= kbreak ? kjump : 0) + 8 * fq;
    const bf16_t* bp = Bt + (size_t)(col_base + fr) * K + k0 + 8 * fq;
#pragma unroll 1
    for (int kb = 0; kb < NKS; kb += 4) {
        bf16x8 af[MTW][4], bfm[NTW][4];
#pragma unroll
        for (int mt = 0; mt < MTW; ++mt)
#pragma unroll
            for (int j = 0; j < 4; ++j) af[mt][j] = *(const bf16x8*)(ap + (size_t)(16 * mt) * lda + 32 * (kb + j));
#pragma unroll
        for (int nt = 0; nt < NTW; ++nt)
#pragma unroll
            for (int j = 0; j < 4; ++j) bfm[nt][j] = *(const bf16x8*)(bp + (size_t)(16 * nt) * K + 32 * (kb + j));
        __builtin_amdgcn_sched_barrier(0);
#pragma unroll
        for (int j = 0; j < 4; ++j)
#pragma unroll
            for (int mt = 0; mt < MTW; ++mt)
#pragma unroll
                for (int nt = 0; nt < NTW; ++nt) acc[mt][nt] = __builtin_amdgcn_mfma_f32_16x16x32_bf16(bfm[nt][j], af[mt][j], acc[mt][nt], 0, 0, 0);
        __builtin_amdgcn_sched_barrier(0);
    }
    LAS f32x4* part = (LAS f32x4*)lds;
    if (kq > 0) {
#pragma unroll
        for (int mt = 0; mt < MTW; ++mt)
#pragma unroll
            for (int nt = 0; nt < NTW; ++nt) part[(((mh * (KQ - 1) + (kq - 1)) * MTW + mt) * NTW + nt) * 64 + lane] = acc[mt][nt];
    }
    __syncthreads();
    if (kq == 0) {
#pragma unroll
        for (int q = 0; q < KQ - 1; ++q)
#pragma unroll
            for (int mt = 0; mt < MTW; ++mt)
#pragma unroll
                for (int nt = 0; nt < NTW; ++nt) acc[mt][nt] += part[(((mh * (KQ - 1) + q) * MTW + mt) * NTW + nt) * 64 + lane];
        E(acc, r0, col_base, fr, fq);
    }
    __syncthreads();
}
struct SEpiProj {
    bf16_t* O;
    template <int MTW, int NTW> __device__ __forceinline__ void operator()(const f32x4 (&acc)[MTW][NTW], int r0, int c0, int fr, int fq) const {
#pragma unroll
        for (int mt = 0; mt < MTW; ++mt)
#pragma unroll
            for (int nt = 0; nt < NTW; ++nt) { const f32x4 v = acc[mt][nt]; u32x2 w; w.x = pk2(v[0], v[1]); w.y = pk2(v[2], v[3]);
                *(u32x2*)(O + (size_t)(r0 + 16 * mt + fr) * LDP + c0 + 16 * nt + 4 * fq) = w; }
    }
};
template <int MODE> struct SEpiResid {
    const float* xold; bf16_t* xbf; float* ssq;
    template <int MTW, int NTW> __device__ __forceinline__ void operator()(const f32x4 (&acc)[MTW][NTW], int r0, int c0, int fr, int fq) const {
        static_assert(MTW == 1 && NTW == 4, "SEpiResid: 16 x 64 block");
        const int row = r0 + fr; float s = 0.f;
#pragma unroll
        for (int nt = 0; nt < NTW; ++nt) { const size_t off = (size_t)row * DM + c0 + 16 * nt + 4 * fq; f32x4 o;
            if (MODE == 0) o = *(const f32x4*)(xold + off);
            else { const u32x2 w = *(const u32x2*)(xbf + off); o = (f32x4){bflo(w.x), bfhi(w.x), bflo(w.y), bfhi(w.y)}; }
            const f32x4 v = o + acc[0][nt];
            u32x2 w; w.x = pk2(v[0], v[1]); w.y = pk2(v[2], v[3]); *(u32x2*)(xbf + off) = w;
            s += (v[0] * v[0] + v[1] * v[1]) + (v[2] * v[2] + v[3] * v[3]); }
        s = xsum32(xsum16(s));
        if (fq == 0) ssq[(size_t)row * 16 + (c0 >> 6)] = s;
    }
};

template <int W>
__device__ __forceinline__ void pool_build(LAS unsigned char* dimg, const LAS float* rr, const bf16_t* mb, const bf16_t* hb, int hp, int g, int tid, int ntok, int pos0) {
    constexpr int NR = W + 7;
    const int seg = tid >> 5, chk = tid & 31, t0 = 8 * seg, cb = 256 * g + 8 * chk;
    const LAS float* rq = rr + (t0 - (W - 1) + 15);
    u32x4 raw[NR];
#pragma unroll
    for (int k = 0; k < NR; ++k) {
        const int t = t0 - (W - 1) + k, tc = t < ntok ? t : ntok - 1;
        const bf16_t* p = (t >= 0) ? mb + (size_t)tc * LDP + cb : hb + (size_t)(PST + t) * hp + cb;
        raw[k] = *(const u32x4*)p;
    }
    float s[8];
#pragma unroll
    for (int e = 0; e < 8; ++e) s[e] = 0.f;
#pragma unroll
    for (int k = 0; k < W - 1; ++k) { float f[8]; unpack8(raw[k], f); const float r = rq[k];
#pragma unroll
        for (int e = 0; e < 8; ++e) s[e] += f[e] * r; }
#pragma unroll
    for (int i = 0; i < 8; ++i) {
        const int t = t0 + i; float cur[8]; unpack8(raw[i + W - 1], cur); const float rc = rq[i + W - 1];
#pragma unroll
        for (int e = 0; e < 8; ++e) { cur[e] *= rc; s[e] += cur[e]; }
        const int cnt = (pos0 + t + 1 < W) ? (pos0 + t + 1) : W; const float inv = 1.0f / (float)cnt;
        u32x4 o; o.x = pk2(s[0] * inv - cur[0], s[1] * inv - cur[1]); o.y = pk2(s[2] * inv - cur[2], s[3] * inv - cur[3]);
        o.z = pk2(s[4] * inv - cur[4], s[5] * inv - cur[5]); o.w = pk2(s[6] * inv - cur[6], s[7] * inv - cur[7]);
        *(LAS u32x4*)(dimg + 512 * t + 16 * (chk ^ (t & 15))) = o;
        u32x4 ro = raw[i]; asm volatile("" : "+v"(ro.x), "+v"(ro.y), "+v"(ro.z), "+v"(ro.w));
        float old[8]; unpack8(ro, old); const float r0 = rq[i];
#pragma unroll
        for (int e = 0; e < 8; ++e) s[e] -= old[e] * r0;
    }
}

__device__ __forceinline__ void mixer_tile(const Args& a, LAS unsigned char* lds, int tid_in, int wave, int layer, int tile, int h_lo, int h_hi, int g_lo, int g_hi, int dry = 0) {
    int tid = tid_in; asm volatile("" : "+v"(tid));
    const int lane = tid & 63;
    unsigned char* ws = a.ws;
    bf16_t* proj = (bf16_t*)(ws + WS_PROJ);
    const float* ssq = (const float*)(ws + WS_SSQ);
    const bool samp = tile >= NPT; const int S = tile - NPT;
    const int row0 = samp ? MP + DSEQ * S : tile * 128;
    const int ntok = samp ? DSEQ : 128;
    const int pos0 = samp ? PAST : (tile & 31) * 128;
    const bool has_prev = samp || (tile & 31) != 0;
    const bf16_t* hs = (const bf16_t*)(ws + WS_HS) + ((size_t)layer * 8 + (samp ? S : 0)) * PST * DM;
    const float* ln_g = a.in[5] + layer * DM; const float* ln_b = a.in[6] + layer * DM;
    const bf16_t* wsp = (const bf16_t*)(ws + WS_WSP) + (size_t)layer * 8 * 16384;
    const float* b_sp = a.in[8] + layer * 8 * 128;
    const bf16_t* wpt = (const bf16_t*)(ws + WS_WPT) + (size_t)layer * 4 * 65536;
    const float* pscale = a.in[10] + layer * DM;
    LAS float* rr = (LAS float*)(lds + SC_OFF); LAS float* mu = rr + 144; LAS float* sv = mu + 128;
    const int fr = lane & 15, fq = lane >> 4;

    if (tid < 143) {
        const int t = tid - 15; float r = 0.f;
        const bool from_rows = (t >= 0) ? (t < ntok) : (!samp && has_prev);
        if (from_rows) { const f32x4* p = (const f32x4*)(ssq + (size_t)(row0 + t) * 16); const f32x4 x0 = p[0], x1 = p[1], x2 = p[2], x3 = p[3];
            const float s = ((x0.x + x0.y) + (x0.z + x0.w)) + ((x1.x + x1.y) + (x1.z + x1.w)) + ((x2.x + x2.y) + (x2.z + x2.w)) + ((x3.x + x3.y) + (x3.z + x3.w));
            r = rsqrt_f(s * (1.0f / DM) + EPS); }
        else if (t < 0 && samp) r = 1.f;
        rr[tid] = r;
    }
    __syncthreads();
    if (h_hi > h_lo) {
        if (!samp) {
            if (tid < 128) { const f32x4* p = (const f32x4*)((const float*)(ws + WS_VST) + (size_t)(row0 + tid) * 32); float s = 0.f, q = 0.f;
#pragma unroll
                for (int j = 0; j < 8; ++j) { const f32x4 x = p[j]; s += x.x + x.z; q += x.y + x.w; }
                const float m = s * (1.0f / DM); float var = q * (1.0f / DM) - m * m; var = var > 0.f ? var : 0.f; const float r = rr[tid + 15];
                mu[tid] = m; sv[tid] = r * rsqrt_f(r * r * var + EPS); }
        } else {
#pragma unroll 1
            for (int i0 = 0; i0 < 1; ++i0) {
                const int tb = 4 * wave;
                u32x4 ra[4], rb[4];
#pragma unroll
                for (int i = 0; i < 4; ++i) { const u32x4* p = (const u32x4*)(proj + (size_t)(row0 + tb + i) * LDP + 1024); ra[i] = p[lane]; rb[i] = p[lane + 64]; }
#pragma unroll
                for (int i = 0; i < 4; ++i) { float f[8], s = 0.f, q = 0.f; unpack8(ra[i], f);
#pragma unroll
                    for (int e = 0; e < 8; ++e) { s += f[e]; q += f[e] * f[e]; }
                    unpack8(rb[i], f);
#pragma unroll
                    for (int e = 0; e < 8; ++e) { s += f[e]; q += f[e] * f[e]; }
                    s = wave_sum(s); q = wave_sum(q);
                    const float m = s * (1.0f / DM); float var = q * (1.0f / DM) - m * m; var = var > 0.f ? var : 0.f; const float r = rr[tb + i + 15];
                    if (lane == 0) { mu[tb + i] = m; sv[tb + i] = r * rsqrt_f(r * r * var + EPS); } }
            }
        }
        __syncthreads();
    }
    if (h_hi > h_lo) {
        const int ch8 = tid & 15, tk0 = tid >> 4;
        const int Gw = ch8 >> 2, q8 = ch8 & 3;
        const int wi = wave & 3, wc2 = wave >> 2, it0 = wi, it1 = 7 - wi;
        u32x4 raw[4], uu[2][2], zz[2][2];
#pragma unroll
        for (int i = 0; i < 4; ++i) { const int tok = tk0 + 32 * i, tc = tok < ntok ? tok : ntok - 1; raw[i] = *(const u32x4*)(proj + (size_t)(row0 + tc) * LDP + 1024 + 128 * h_lo + 8 * ch8); }
#pragma unroll
        for (int sel = 0; sel < 2; ++sel) { const int i = 16 * (sel ? it1 : it0) + fr;
#pragma unroll
            for (int G2 = 0; G2 < 2; ++G2) { const bf16_t* pu = proj + (size_t)(row0 + (i < ntok ? i : ntok - 1)) * LDP + 128 * h_lo + 32 * (2 * wc2 + G2) + 8 * fq; uu[sel][G2] = *(const u32x4*)pu; zz[sel][G2] = *(const u32x4*)(pu + 2048); } }
#pragma unroll 1
        for (int h = h_lo; h < h_hi; ++h) {
            LAS unsigned char* img = lds + (h & 1) * 32768;
            { const f32x4 g0 = *(const f32x4*)(ln_g + 128 * h + 8 * ch8), g1 = *(const f32x4*)(ln_g + 128 * h + 8 * ch8 + 4);
              const f32x4 b0 = *(const f32x4*)(ln_b + 128 * h + 8 * ch8), b1 = *(const f32x4*)(ln_b + 128 * h + 8 * ch8 + 4);
#pragma unroll
              for (int i = 0; i < 4; ++i) { const int tok = tk0 + 32 * i; float f[8]; unpack8(raw[i], f);
                  float m = 0.f, sc = 0.f; if (tok < ntok) { m = mu[tok]; sc = sv[tok]; }
                  f32x4 y0, y1;
                  y0.x = (f[0] - m) * sc * g0.x + b0.x; y0.y = (f[1] - m) * sc * g0.y + b0.y; y0.z = (f[2] - m) * sc * g0.z + b0.z; y0.w = (f[3] - m) * sc * g0.w + b0.w;
                  y1.x = (f[4] - m) * sc * g1.x + b1.x; y1.y = (f[5] - m) * sc * g1.y + b1.y; y1.z = (f[6] - m) * sc * g1.z + b1.z; y1.w = (f[7] - m) * sc * g1.w + b1.w;
                  if (tok >= ntok) { y0 = (f32x4){0.f, 0.f, 0.f, 0.f}; y1 = y0; }
                  u32x2 p0, p1; p0.x = pk2(y0.x, y0.y); p0.y = pk2(y0.z, y0.w); p1.x = pk2(y1.x, y1.y); p1.y = pk2(y1.z, y1.w);
                  *(LAS u32x2*)(img + off_b(tok, 4 * Gw + (q8 >> 1)) + 8 * (q8 & 1)) = p0;
                  *(LAS u32x2*)(img + off_b(tok, 4 * Gw + 2 + (q8 >> 1)) + 8 * (q8 & 1)) = p1;
                  if (samp && tok < ntok) { float* cv = a.out + OUT_CV + (((size_t)layer * 8 + S) * DSEQ + tok) * DM + 128 * h + 8 * ch8; *(f32x4*)cv = y0; *(f32x4*)(cv + 4) = y1; }
              } }
            u32x4 un[2][2], zn[2][2];
            { const int hn = (h + 1 < h_hi) ? h + 1 : h;
#pragma unroll
                for (int i = 0; i < 4; ++i) { const int tok = tk0 + 32 * i, tc = tok < ntok ? tok : ntok - 1; raw[i] = *(const u32x4*)(proj + (size_t)(row0 + tc) * LDP + 1024 + 128 * hn + 8 * ch8); }
#pragma unroll
                for (int sel = 0; sel < 2; ++sel) { const int i = 16 * (sel ? it1 : it0) + fr;
#pragma unroll
                    for (int G2 = 0; G2 < 2; ++G2) { const bf16_t* pu = proj + (size_t)(row0 + (i < ntok ? i : ntok - 1)) * LDP + 128 * hn + 32 * (2 * wc2 + G2) + 8 * fq; un[sel][G2] = *(const u32x4*)pu; zn[sel][G2] = *(const u32x4*)(pu + 2048); } }
            }
            const bf16_t* wh = wsp + h * 16384;
            bf16x8 w0[2], w1[4];
#pragma unroll
            for (int ks = 0; ks < 2; ++ks) w0[ks] = *(const bf16x8*)(wh + (16 * it0 + fr) * 128 + 32 * ks + 8 * fq);
#pragma unroll
            for (int ks = 0; ks < 4; ++ks) w1[ks] = *(const bf16x8*)(wh + (16 * it1 + fr) * 128 + 32 * ks + 8 * fq);
            __syncthreads();
            f32x4 acc[2][2][2];
#pragma unroll
            for (int G2 = 0; G2 < 2; ++G2)
#pragma unroll
                for (int n = 0; n < 2; ++n) { const int c = 2 * (2 * wc2 + G2) + n; f32x4 a0 = (f32x4){0.f, 0.f, 0.f, 0.f}, a1 = a0;
#pragma unroll
                    for (int ks = 0; ks < 4; ++ks) {
                        const s16x4 lo = vtr(img + tr_addr16(lane, c, ks, 0)), hi = vtr(img + tr_addr16(lane, c, ks, 1));
                        const bf16x8 af = (bf16x8){lo[0], lo[1], lo[2], lo[3], hi[0], hi[1], hi[2], hi[3]};
                        if (ks < 2) a0 = __builtin_amdgcn_mfma_f32_16x16x32_bf16(af, w0[ks], a0, 0, 0, 0);
                        a1 = __builtin_amdgcn_mfma_f32_16x16x32_bf16(af, w1[ks], a1, 0, 0, 0);
                    }
                    acc[G2][n][0] = a0; acc[G2][n][1] = a1; }
#pragma unroll
            for (int sel = 0; sel < 2; ++sel) { const int i = 16 * (sel ? it1 : it0) + fr;
                if (i < ntok) { const float r = rr[i + 15], bs = b_sp[h * 128 + i];
#pragma unroll
                    for (int G2 = 0; G2 < 2; ++G2) { float fu[8], fz[8], o[8]; unpack8(uu[sel][G2], fu); unpack8(zz[sel][G2], fz);
#pragma unroll
                        for (int e = 0; e < 8; ++e) { const float gate = acc[G2][e >> 2][sel][e & 3] + bs; o[e] = (r * fu[e]) * gate * silu_f(r * fz[e]); }
                        u32x4 w; w.x = pk2(o[0], o[1]); w.y = pk2(o[2], o[3]); w.z = pk2(o[4], o[5]); w.w = pk2(o[6], o[7]);
                        if (!dry) *(u32x4*)(proj + (size_t)(row0 + i) * LDP + 128 * h + 32 * (2 * wc2 + G2) + 8 * fq) = w; else asm volatile("" :: "v"(w)); } } }
#pragma unroll
            for (int sel = 0; sel < 2; ++sel)
#pragma unroll
                for (int G2 = 0; G2 < 2; ++G2) { uu[sel][G2] = un[sel][G2]; zz[sel][G2] = zn[sel][G2]; }
        }
    }
    __syncthreads();
    if (g_lo == 0 && g_hi > 0 && (samp || (tile & 31) == 31)) {
        const int tfirst = ntok - PST;
        float* so = samp ? a.out + OUT_SPS + ((size_t)layer * 8 + S) * PST * DM : a.out + OUT_SPP + ((size_t)layer * 8 + (tile >> 5)) * PST * DM;
        for (int q = tid; q < PST * 128; q += 512) { const int s = q >> 7, ch = q & 127, t = tfirst + s; const float r = rr[t + 15];
            const u32x4 w = *(const u32x4*)(proj + (size_t)(row0 + t) * LDP + 3072 + 8 * ch); float f[8]; unpack8(w, f);
            *(f32x4*)(so + (size_t)s * DM + 8 * ch) = (f32x4){f[0] * r, f[1] * r, f[2] * r, f[3] * r}; *(f32x4*)(so + (size_t)s * DM + 8 * ch + 4) = (f32x4){f[4] * r, f[5] * r, f[6] * r, f[7] * r}; }
    }
    {
#pragma unroll 1
        for (int g = g_lo; g < g_hi; ++g) {
            LAS unsigned char* dimg = lds + (g & 1) * 65536;
            int tl = tid; asm volatile("" : "+v"(tl));
            const int lfr = tl & 15, lfq = (tl >> 4) & 3;
            const bf16_t* wg = wpt + (size_t)g * 65536;
            bf16x8 afr[2][8];
#pragma unroll
            for (int n = 0; n < 2; ++n) { const int dout = 32 * wave + 8 * (lfr >> 2) + 4 * n + (lfr & 3);
#pragma unroll
                for (int ks = 0; ks < 8; ++ks) afr[n][ks] = *(const bf16x8*)(wg + dout * 256 + 32 * ks + 8 * lfq); }
            const bf16_t* mb = proj + (size_t)row0 * LDP + 3072;
            const bf16_t* hb = samp ? hs : (has_prev ? mb - (size_t)PST * LDP : mb); const int hp = samp ? DM : (has_prev ? LDP : 0);
            if (dry == 3) { }
            else if (g == 0) pool_build<2>(dimg, rr, mb, hb, hp, g, tl, ntok, pos0);
            else if (g == 1) pool_build<4>(dimg, rr, mb, hb, hp, g, tl, ntok, pos0);
            else if (g == 2) pool_build<8>(dimg, rr, mb, hb, hp, g, tl, ntok, pos0);
            else pool_build<16>(dimg, rr, mb, hb, hp, g, tl, ntok, pos0);
            __syncthreads();
            if (dry != 2) {
            const int d8 = 256 * g + 32 * wave + 8 * lfq;
            u32x4 zw[8];
#pragma unroll
            for (int tt = 0; tt < 8; ++tt) { const int i = 16 * tt + lfr; zw[tt] = *(const u32x4*)(proj + (size_t)(row0 + (i < ntok ? i : ntok - 1)) * LDP + 4096 + d8); }
            f32x4 acc[2][8];
#pragma unroll
            for (int n = 0; n < 2; ++n)
#pragma unroll
                for (int tt = 0; tt < 8; ++tt) acc[n][tt] = (f32x4){0.f, 0.f, 0.f, 0.f};
#pragma unroll
            for (int ks = 0; ks < 8; ++ks) {
#pragma unroll
                for (int tt = 0; tt < 8; ++tt) { const bf16x8 bfr = *(const LAS bf16x8*)(dimg + 512 * (16 * tt + lfr) + 16 * ((4 * ks + lfq) ^ lfr));
                    acc[0][tt] = __builtin_amdgcn_mfma_f32_16x16x32_bf16(afr[0][ks], bfr, acc[0][tt], 0, 0, 0);
                    acc[1][tt] = __builtin_amdgcn_mfma_f32_16x16x32_bf16(afr[1][ks], bfr, acc[1][tt], 0, 0, 0); }
            }
            const f32x4 s0 = *(const f32x4*)(pscale + d8), s1 = *(const f32x4*)(pscale + d8 + 4);
            const float sc[8] = {s0.x, s0.y, s0.z, s0.w, s1.x, s1.y, s1.z, s1.w};
#pragma unroll
            for (int tt = 0; tt < 8; ++tt) { const int i = 16 * tt + lfr;
                if (i < ntok) { const float r = rr[i + 15]; float fz[8], o[8]; unpack8(zw[tt], fz);
#pragma unroll
                    for (int e = 0; e < 8; ++e) o[e] = acc[e >> 2][tt][e & 3] * sc[e] * silu_f(r * fz[e]);
                    u32x4 w; w.x = pk2(o[0], o[1]); w.y = pk2(o[2], o[3]); w.z = pk2(o[4], o[5]); w.w = pk2(o[6], o[7]);
                    if (!dry) *(u32x4*)(proj + (size_t)(row0 + i) * LDP + (samp ? 4096 : 1024) + d8) = w; else asm volatile("" :: "v"(w)); } }
            } else { asm volatile("" :: "v"(afr[0][0]), "v"(afr[1][7])); }
        }
    }
    __syncthreads();
}

__device__ __forceinline__ void final_norm(const Args& a, int gw, int NGW) {
    int tl = threadIdx.x; asm volatile("" : "+v"(tl)); const int lane = tl & 63;
    const float* ssq = (const float*)(a.ws + WS_SSQ); const float* fg = a.in[12]; const bf16_t* xb = (const bf16_t*)(a.ws + WS_XBF);
    f32x4 gv[2][2];
#pragma unroll
    for (int j = 0; j < 2; ++j) { gv[j][0] = *(const f32x4*)(fg + 8 * (lane + 64 * j)); gv[j][1] = *(const f32x4*)(fg + 8 * (lane + 64 * j) + 4); }
#pragma unroll 2
    for (int m = gw; m < MT; m += NGW) {
        float s = (lane < 16) ? ssq[(size_t)m * 16 + lane] : 0.f; s = wave_sum(s);
        const float r = rsqrt_f(s * (1.0f / DM) + EPS);
        const u32x4* xr = (const u32x4*)(xb + (size_t)m * DM); float* yr = a.out + OUT_Y + (size_t)m * DM;
#pragma unroll
        for (int j = 0; j < 2; ++j) { const u32x4 w = xr[lane + 64 * j]; float f[8]; unpack8(w, f);
            *(f32x4*)(yr + 8 * (lane + 64 * j)) = (f32x4){f[0], f[1], f[2], f[3]} * r * gv[j][0];
            *(f32x4*)(yr + 8 * (lane + 64 * j) + 4) = (f32x4){f[4], f[5], f[6], f[7]} * r * gv[j][1]; }
    }
}

constexpr size_t WS_CTL = 0, CTL_ZERO_BYTES = 65536;
constexpr int BAR_ST_OFF = SC_OFF + 4096;
#define XB_TMO      128
#define XB_XCNT(j)  (256  + 64 * (j))
#define XB_XSUB(j)  (1280 + 64 * (j))
#define XB_XGEN(j)  (2304 + 64 * (j))
#define XB_TOP      3328
#define XB_TOPGEN   3392
#define XCD_BAR_WORDS 3456
#define XB_SPIN_CAP (1u << 18)

__device__ __forceinline__ unsigned xb_ld(unsigned* p)              { return __hip_atomic_load(p, __ATOMIC_RELAXED, __HIP_MEMORY_SCOPE_AGENT); }
__device__ __forceinline__ unsigned xb_add(unsigned* p, unsigned v) { return __hip_atomic_fetch_add(p, v, __ATOMIC_RELAXED, __HIP_MEMORY_SCOPE_AGENT); }
__device__ __forceinline__ unsigned xb_xcc_id() { return (unsigned)__builtin_amdgcn_s_getreg((3 << 11) | 20) & 0xFu; }
#define XB_SPIN(cond, bar) do { unsigned _sp = 0; while (cond) { __builtin_amdgcn_s_sleep(1); \
    if ((++_sp & 255u) == 0u) { if (xb_ld(&(bar)[XB_TMO])) break; if (_sp > XB_SPIN_CAP) { atomicAdd(&(bar)[XB_TMO], 1u); break; } } } } while (0)

struct XcdBarrier {
    unsigned* bar; unsigned x;
    volatile LAS unsigned* st;
};

__device__ __forceinline__ XcdBarrier xcd_barrier_post(unsigned* bar, volatile LAS unsigned* st) {
    XcdBarrier b; b.bar = bar; b.x = xb_xcc_id(); b.st = st;
    if (threadIdx.x == 0) (void)xb_add(&bar[XB_XCNT(b.x)], 1u);
    return b;
}
__device__ __forceinline__ void xcd_barrier_complete(unsigned* bar, unsigned x, unsigned& nloc, unsigned& nx) {
    const unsigned G = gridDim.x * gridDim.y * gridDim.z;
    unsigned sum, cnt, mine, sp = 0u;
    for (;;) {
        sum = 0u; cnt = 0u; mine = 0u;
#pragma unroll
        for (unsigned j = 0; j < 16; ++j) { const unsigned c = xb_ld(&bar[XB_XCNT(j)]); sum += c; cnt += (c > 0u) ? 1u : 0u; mine = (j == x) ? c : mine; }
        if (sum == G) break;
        __builtin_amdgcn_s_sleep(1);
        if ((++sp & 255u) == 0u) { if (xb_ld(&bar[XB_TMO])) break; if (sp > XB_SPIN_CAP) { atomicAdd(&bar[XB_TMO], 1u); break; } }
    }
    nloc = mine > 0u ? mine : 1u; nx = cnt > 0u ? cnt : 1u;
}

__device__ __forceinline__ void xcd_barrier(const XcdBarrier& b) {
    asm volatile("s_waitcnt vmcnt(0)" ::: "memory");
    __syncthreads();
    if (threadIdx.x == 0) {
        unsigned* bar = b.bar;
        __builtin_amdgcn_s_waitcnt(0);
        unsigned nloc = b.st[0], nx = b.st[1];
        if (nloc == 0u) { xcd_barrier_complete(bar, b.x, nloc, nx); b.st[0] = nloc; b.st[1] = nx; }
        const unsigned old = xb_add(&bar[XB_XSUB(b.x)], 1u);
        const unsigned gen = old / nloc;
        if (old + 1u == (gen + 1u) * nloc) {
            __builtin_amdgcn_fence(__ATOMIC_RELEASE, "agent");
            asm volatile("s_waitcnt vmcnt(0)" ::: "memory");
            const unsigned og = xb_add(&bar[XB_TOP], 1u);
            const unsigned tg = og / nx;
            if (og + 1u == (tg + 1u) * nx) xb_add(&bar[XB_TOPGEN], 1u);
            else XB_SPIN(xb_ld(&bar[XB_TOPGEN]) == tg, bar);
            __builtin_amdgcn_fence(__ATOMIC_ACQUIRE, "agent");
            xb_add(&bar[XB_XGEN(b.x)], 1u);
            asm volatile("s_waitcnt vmcnt(0)" ::: "memory");
        } else {
            XB_SPIN(xb_ld(&bar[XB_XGEN(b.x)]) == gen, bar);
            __builtin_amdgcn_fence(__ATOMIC_ACQUIRE, "agent");
            asm volatile("s_waitcnt vmcnt(0)" ::: "memory");
        }
    }
    __syncthreads();
}

constexpr int N_PHASES = 8;
#ifndef MK_PROG
#define MK_PROG {0, 1, 2, 3, 4, 5, 6, 7}
#endif
struct KArgs { Args a; int nprog; int prog[15]; };
template <int COOP>
__global__ void __launch_bounds__(512, 2) fwd_kernel(KArgs ka) {
    extern __shared__ __attribute__((aligned(16))) unsigned char lds_raw[];
    LAS unsigned char* lds = (LAS unsigned char*)lds_raw;
    const Args& a = ka.a;
    const int wave = __builtin_amdgcn_readfirstlane(threadIdx.x >> 6);
    const int G = gridDim.x, bx = blockIdx.x;
    const int vcu = (G % 8 == 0) ? (bx % 8) * (G / 8) + bx / 8 : bx;
    const int gw = vcu * 8 + wave, NGW = G * 8;
    unsigned char* ws_in = a.ws;
    XcdBarrier bar; bar.bar = nullptr; bar.x = 0; bar.st = nullptr;
    if (COOP == 2) {
        volatile LAS unsigned* st = (volatile LAS unsigned*)(lds + BAR_ST_OFF);
        if (threadIdx.x < 2) st[threadIdx.x] = 0u;
        __syncthreads();
        bar = xcd_barrier_post((unsigned*)(ws_in + WS_CTL), st);
    }
#pragma unroll 1
    for (int pi = 0; pi < ka.nprog; ++pi) {
        const int ph = ka.prog[pi];
        unsigned char* ws = ws_in; asm volatile("" : "+s"(ws));
        if (ph == 0) { p0_prep(a, lds, gw, NGW, wave); __syncthreads(); }
        else if (ph == 7) final_norm(a, gw, NGW);
        else if (ph == 8) { }
#ifdef MK_PROBES
        else if (ph == 9) {
            pg8::Gemm g{(const bf16_t*)(ws + WS_XBF), (const bf16_t*)(ws + WS_W1T), MP, NPROJ, DM, DM, (unsigned*)(ws + WS_DUMMY)};
            pg8::StaticOrder S; S.init(MP, NPROJ, G, bx); pg8::EpiNone E;
            pg8::gemm_phase<pg8::EpiNone, pg8::StaticOrder, PG8_ALIGN, PG8_SP2>(lds, g, S, E);
        }
        else if (ph == 11) { for (int tile = bx; tile < NPT; tile += G) mixer_tile(a, lds, threadIdx.x, wave, 0, tile, 0, 8, 0, 0, 1); }
        else if (ph == 12) { for (int tile = bx; tile < NPT; tile += G) mixer_tile(a, lds, threadIdx.x, wave, 0, tile, 0, 0, 0, 4, 1); }
        else if (ph == 13) { for (int tile = bx; tile < NPT; tile += G) mixer_tile(a, lds, threadIdx.x, wave, 0, tile, 0, 0, 0, 4, 2); }
        else if (ph == 14) { for (int tile = bx; tile < NPT; tile += G) mixer_tile(a, lds, threadIdx.x, wave, 0, tile, 0, 0, 0, 4, 3); }
        else if (ph == 10) {
            pg8::Gemm g{(const bf16_t*)(ws + WS_XBF), (const bf16_t*)(ws + WS_W1T), MP, NPROJ, DM, DM, (unsigned*)(ws + WS_DUMMY)};
            pg8::StaticOrder S; S.init(MP, NPROJ, G, bx); pg8::EpiSame E{(bf16_t*)(ws + WS_PROJ), LDP, bx & 127, bx >> 7};
            pg8::gemm_phase<pg8::EpiSame, pg8::StaticOrder, PG8_ALIGN, PG8_SP2>(lds, g, S, E);
        }
#endif
        else if (ph >= 15) { }
        else {
            const int layer = (ph - 1) / 3, kind = (ph - 1) % 3;
            if (kind == 0) {
                const bf16_t* w1t = (const bf16_t*)(ws + WS_W1T) + (size_t)layer * NPROJ * DM;
                pg8::Gemm g{(const bf16_t*)(ws + WS_XBF), w1t, MP, NPROJ, DM, DM, (unsigned*)(ws + WS_DUMMY)};
                pg8::StaticOrder S; S.init(MP, NPROJ, G, bx);
                pg8::EpiBf16 E{(bf16_t*)(ws + WS_PROJ), LDP, (float*)(ws + WS_VST), lds + EPI_OFF};
                pg8::gemm_phase<pg8::EpiBf16, pg8::StaticOrder, PG8_ALIGN, PG8_SP2>(lds, g, S, E);
                SEpiProj SE{(bf16_t*)(ws + WS_PROJ)};
                for (int it = bx; it < 256; it += G) small_gemm<2, 5, 4>(lds, (const bf16_t*)(ws + WS_XBF), DM, 1 << 30, 0, w1t, DM, MP + 64 * (it & 3), 80 * (it >> 2), SE);
            } else if (kind == 1) {
                for (int tile = bx; tile < NPT; tile += G) mixer_tile(a, lds, threadIdx.x, wave, layer, tile, 0, 8, 0, 4);
                for (int it = bx; it < NST * 12; it += G) { const int S = it / 12, part = it % 12;
                    if (part < 8) mixer_tile(a, lds, threadIdx.x, wave, layer, NPT + S, part, part + 1, 0, 0);
                    else mixer_tile(a, lds, threadIdx.x, wave, layer, NPT + S, 0, 0, part - 8, part - 7); }
            } else {
                const bf16_t* w2t = (const bf16_t*)(ws + WS_W2T) + (size_t)layer * DM * DMIX;
                pg8::Gemm g{(const bf16_t*)(ws + WS_PROJ), w2t, MP, DM, DMIX, LDP, (unsigned*)(ws + WS_DUMMY)};
                pg8::StaticOrder S; S.init(MP, DM, G, bx);
                bf16_t* xbf = (bf16_t*)(ws + WS_XBF); float* ssq = (float*)(ws + WS_SSQ);
                {
                    pg8::EpiResid<1> E{nullptr, xbf, ssq}; SEpiResid<1> SE{nullptr, xbf, ssq};
                    pg8::gemm_phase<pg8::EpiResid<1>, pg8::StaticOrder, PG8_ALIGN, PG8_SP2>(lds, g, S, E);
                    for (int it = bx; it < 256; it += G) small_gemm<1, 4, 8>(lds, (const bf16_t*)(ws + WS_PROJ), LDP, 1024, 3072, w2t, DMIX, MP + 16 * (it & 15), 64 * (it >> 4), SE);
                }
            }
        }
        if (pi + 1 < ka.nprog) { if (COOP == 1) cg::this_grid().sync(); else if (COOP == 2) xcd_barrier(bar); }
    }
}

extern "C" void kernel_launch(void* const* d_in, const int* in_sizes, int n_in, void* d_out, int out_size, void* d_ws, size_t ws_size, hipStream_t stream) {
    static int grid = 0;
    if (grid == 0) {
        if (n_in != 13 || in_sizes[0] != MP * DM || (size_t)out_size != OUT_END || ws_size < WS_END) {
            fprintf(stderr, "kernel_launch: unexpected shapes: n_in %d in0 %d out %d ws %zu (need %zu); nothing launched\n", n_in, n_in > 0 ? in_sizes[0] : -1, out_size, ws_size, (size_t)WS_END); grid = -1; return; }
        int dev = 0, cus = 0, per_cu = 0;
        (void)hipGetDevice(&dev); (void)hipDeviceGetAttribute(&cus, hipDeviceAttributeMultiprocessorCount, dev);
        (void)hipFuncSetAttribute((const void*)fwd_kernel<MK_COOP>, hipFuncAttributeMaxDynamicSharedMemorySize, LDS_BYTES);
        (void)hipOccupancyMaxActiveBlocksPerMultiprocessor(&per_cu, (const void*)fwd_kernel<MK_COOP>, 512, LDS_BYTES);
        (void)hipGetLastError();
        if (per_cu < 1) { fprintf(stderr, "kernel_launch: occupancy query says %d blocks per CU\n", per_cu); per_cu = 1; }
        grid = cus * 1;
    }
    if (grid < 0) return;
    KArgs ka{};
    for (int i = 0; i < 13; ++i) ka.a.in[i] = (const float*)d_in[i];
    ka.a.out = (float*)d_out; ka.a.ws = (unsigned char*)d_ws;
    const int prog[] = MK_PROG; const int np = (int)(sizeof(prog) / sizeof(prog[0]));
#if MK_COOP == 1
    ka.nprog = np; for (int i = 0; i < np; ++i) ka.prog[i] = prog[i];
    void* args[] = {&ka};
    hipError_t e = hipLaunchCooperativeKernel((const void*)fwd_kernel<1>, dim3(grid), dim3(512), args, LDS_BYTES, stream);
    if (e != hipSuccess) fprintf(stderr, "cooperative launch failed: %s (grid %d)\n", hipGetErrorString(e), grid);
#elif MK_COOP == 2
    (void)hipMemsetAsync((char*)d_ws + WS_CTL, 0, CTL_ZERO_BYTES, stream);
    ka.nprog = np; for (int i = 0; i < np; ++i) ka.prog[i] = prog[i];
    hipLaunchKernelGGL(fwd_kernel<2>, dim3(grid), dim3(512), LDS_BYTES, stream, ka);
#else
    for (int p = 0; p < np; ++p) { ka.nprog = 1; ka.prog[0] = prog[p]; hipLaunchKernelGGL(fwd_kernel<0>, dim3(grid), dim3(512), LDS_BYTES, stream, ka); }
#endif
}
```
